# Optimizing an MI355X kernel written in HIP

```python
import math
import jax, jax.numpy as jnp
from jax import lax
import numpy as np

D_MODEL = 1024
BATCH = 16
SEQ = 2048
DEPTH = 1

N_META = 16
D_MIX = D_MODEL
D_HYENA = D_MIX // 2
D_HGRN = D_MIX - D_HYENA
HYENA_ORDER = 2
SHORT_CONV = 3
FILTER_EMB = 33
FILTER_BANDS = (FILTER_EMB - 1) // 2
FILTER_HIDDEN = 64
DECAY_TARGET = 1e-2
FAST_DECAY_PCT = 0.3
SLOW_DECAY_PCT = 1.5
HGRN_HEAD_DIM = 128
HGRN_HEADS = D_HGRN // HGRN_HEAD_DIM
CHUNK = 64
N_GROUPS = 8
EXPERTS_PER_GROUP = 8
N_EXPERTS = N_GROUPS * EXPERTS_PER_GROUP
TOP_K = 2
D_EXPERT = D_MODEL // 2
MOE_BLOCK = 128
D_HYENA_PROJ = (HYENA_ORDER + 1) * D_HYENA
D_HGRN_PROJ = 5 * D_HGRN
D_IN_PROJ = D_HYENA_PROJ + D_HGRN_PROJ
EPS = 1e-6

kernel_name = 'hymba_hyena_hgrn2_hmoe_encoder'


def rms_norm(x, gain):
    xf = x.astype(jnp.float32)
    y = xf * lax.rsqrt(jnp.mean(xf * xf, axis=-1, keepdims=True) + EPS)
    return (y * gain.astype(jnp.float32)).astype(x.dtype)


def centred_short_conv(u, w, b):
    L = u.shape[1]
    half = SHORT_CONV // 2
    up = jnp.pad(u, ((0, 0), (half, SHORT_CONV - 1 - half), (0, 0)))
    y = b
    for j in range(SHORT_CONV):
        y = y + up[:, j:j + L] * w[j]
    return y


def hyena_filter_spectra(L, w1, b1, w2, b2, w3, freq):
    f32 = jnp.float32
    pos = jnp.arange(L, dtype=f32)
    t = pos / max(L - 1, 1)
    bands = jnp.linspace(1e-4, FILTER_BANDS - 1, FILTER_BANDS, dtype=f32)
    ang = (2.0 * math.pi / L) * pos[:, None] * bands[None, :]
    z = jnp.concatenate([t[:, None], jnp.cos(ang), -jnp.sin(ang)], axis=-1)
    fr = freq.astype(f32)
    hid = jnp.sin(fr * (z @ w1.astype(f32) + b1.astype(f32)))
    hid = jnp.sin(fr * (hid @ w2.astype(f32) + b2.astype(f32)))
    filt = (hid @ w3.astype(f32)).reshape(L, 2, HYENA_ORDER, D_HYENA)
    deltas = jnp.abs(jnp.linspace(math.log(DECAY_TARGET) / SLOW_DECAY_PCT,
                                  math.log(DECAY_TARGET) / FAST_DECAY_PCT, D_HYENA, dtype=f32))
    window = jnp.exp(-t[:, None] * deltas[None, :])
    filt = filt * window[:, None, None, :]
    h_fwd, h_bwd = filt[:, 0], filt[:, 1]
    two_sided = jnp.concatenate([h_fwd, jnp.zeros_like(h_fwd[:1]), h_bwd[:0:-1]], axis=0)
    return jnp.fft.rfft(two_sided, axis=0)


def fft_long_conv(u, spec, skip):
    L = u.shape[1]
    uf = u.astype(jnp.float32)
    y = jnp.fft.irfft(jnp.fft.rfft(uf, n=2 * L, axis=1) * spec[None], n=2 * L, axis=1)[:, :L]
    return (y + uf * skip.astype(jnp.float32)).astype(u.dtype)


def hyena_mixer(p, conv_w, conv_b, w1, b1, w2, b2, w3, freq, skip):
    L = p.shape[1]
    u = centred_short_conv(p, conv_w, conv_b)
    z = u[..., :D_HYENA]
    spectra = hyena_filter_spectra(L, w1, b1, w2, b2, w3, freq)
    for n in range(HYENA_ORDER):
        gate = u[..., (n + 1) * D_HYENA:(n + 2) * D_HYENA]
        z = gate * fft_long_conv(z, spectra[:, n], skip[n])
    return z


def chunked_gated_linear_scan(q, k, v, log_f):
    B, T, H, DK = q.shape
    DV = v.shape[-1]
    N = T // CHUNK
    q, k, v, log_f = [a.reshape(B, N, CHUNK, H, a.shape[-1]) for a in (q, k, v, log_f)]
    b = jnp.cumsum(log_f, axis=2)
    b_last = b[:, :, -1]
    b_mid = b[:, :, CHUNK // 2][:, :, None]
    scores = jnp.einsum('bnthd,bnshd->bnhts', q * jnp.exp(b - b_mid), k * jnp.exp(b_mid - b))
    lower_tri = jnp.tril(jnp.ones((CHUNK, CHUNK), dtype=bool))
    scores = jnp.where(lower_tri, scores, 0.0)
    o_intra = jnp.einsum('bnhts,bnshv->bnthv', scores, v)
    chunk_state = jnp.einsum('bnshd,bnshv->bnhdv', k * jnp.exp(b_last[:, :, None] - b), v)
    chunk_decay = jnp.exp(b_last)

    def step(S, inp):
        dec, U = inp
        return dec[..., None] * S + U, S

    S0 = jnp.zeros((B, H, DK, DV), q.dtype)
    _, S_in = lax.scan(step, S0, (jnp.moveaxis(chunk_decay, 1, 0), jnp.moveaxis(chunk_state, 1, 0)))
    S_in = jnp.moveaxis(S_in, 0, 1)
    o_inter = jnp.einsum('bnthd,bnhdv->bnthv', q * jnp.exp(b), S_in)
    return (o_intra + o_inter).reshape(B, T, H, DV)


def hgrn2_mixer(p, lb_f, lb_b, norm_w):
    f32 = jnp.float32
    B, L, _ = p.shape
    q, f_fwd, f_bwd, i_in, g = [p[..., j * D_HGRN:(j + 1) * D_HGRN] for j in range(5)]

    def heads(a):
        return a.reshape(B, L, HGRN_HEADS, HGRN_HEAD_DIM)

    qh = heads(jax.nn.silu(q.astype(f32)))
    vh = heads(i_in.astype(f32))

    def forget(logit, lb):
        lb = lb.astype(f32)
        f = lb + (1.0 - lb) * jax.nn.sigmoid(logit.astype(f32))
        return heads(1.0 - f), heads(jnp.log(f))

    k_f, lf_f = forget(f_fwd, lb_f)
    k_b, lf_b = forget(f_bwd, lb_b)
    n_pad = (-N_META) % CHUNK

    def pad(a):
        return jnp.pad(a, ((0, 0), (n_pad, 0), (0, 0), (0, 0)))

    def flip(a):
        return a[:, ::-1]

    qp, vp = pad(qh), pad(vh)
    o_f = chunked_gated_linear_scan(qp, pad(k_f), vp, pad(lf_f))
    o_b = flip(chunked_gated_linear_scan(flip(qp), flip(pad(k_b)), flip(vp), flip(pad(lf_b))))
    o = (o_f + o_b)[:, n_pad:]
    o = o * lax.rsqrt(jnp.mean(o * o, axis=-1, keepdims=True) + EPS)
    o = o.reshape(B, L, D_HGRN) * norm_w.astype(f32) * jax.nn.silu(g.astype(f32))
    return o.astype(p.dtype)


def hier_moe(h, w_rg, w_re, w_gate, w_up, w_down):
    f32 = jnp.float32
    B, L, D = h.shape
    n_tok = B * L
    hf = h.reshape(n_tok, D)
    g_logits = (hf @ w_rg).astype(f32)
    g_sel = jnp.argmax(g_logits, axis=-1)
    p_group = jnp.take_along_axis(jax.nn.softmax(g_logits, axis=-1), g_sel[:, None], axis=-1)
    e_logits = jnp.einsum('nd,dge->nge', hf, w_re).astype(f32)
    e_logits = e_logits[jnp.arange(n_tok), g_sel]
    p_top, e_top = lax.top_k(jax.nn.softmax(e_logits, axis=-1), TOP_K)
    gate = p_group * p_top / jnp.sum(p_top, axis=-1, keepdims=True)
    expert_id = (g_sel[:, None] * EXPERTS_PER_GROUP + e_top).reshape(-1).astype(jnp.int32)

    M = n_tok * TOP_K
    n_blocks = -(-M // MOE_BLOCK) + N_EXPERTS
    n_slots = n_blocks * MOE_BLOCK
    order = jnp.argsort(expert_id)
    eid_s = expert_id[order]
    tok_s = (jnp.arange(M, dtype=jnp.int32) // TOP_K)[order]
    gate_s = gate.reshape(-1)[order]
    counts = jnp.bincount(expert_id, length=N_EXPERTS)
    padded = (counts + MOE_BLOCK - 1) // MOE_BLOCK * MOE_BLOCK
    start = jnp.cumsum(counts) - counts
    pend = jnp.cumsum(padded)
    dest = (pend - padded)[eid_s] + jnp.arange(M, dtype=jnp.int32) - start[eid_s]
    tok_buf = jnp.zeros((n_slots,), jnp.int32).at[dest].set(tok_s)
    gate_buf = jnp.zeros((n_slots,), f32).at[dest].set(gate_s)
    block_eid = jnp.minimum(
        jnp.searchsorted(pend, jnp.arange(n_blocks, dtype=pend.dtype) * MOE_BLOCK, side='right'),
        N_EXPERTS - 1)
    xb = hf[tok_buf].reshape(n_blocks, MOE_BLOCK, D)

    def expert_block(args):
        xe, e = args
        return (jax.nn.silu(xe @ w_gate[e]) * (xe @ w_up[e])) @ w_down[e]

    yb = lax.map(expert_block, (xb, block_eid)).reshape(n_slots, D)
    y = jnp.zeros_like(hf).at[tok_buf].add(yb * gate_buf[:, None].astype(yb.dtype))
    return y.reshape(B, L, D)


def setup_inputs(seed: int = 0) -> dict:
    key = jax.random.key(seed)
    ks = jax.random.split(key, 25)

    def nrm(k, shape, scale):
        return scale * jax.random.normal(k, shape, jnp.float32)

    return {
        'x': nrm(ks[0], (BATCH, SEQ, D_MODEL), 1.0),
        'meta_tokens': nrm(ks[1], (N_META, D_MODEL), 1.0),
        'w_in': nrm(ks[2], (DEPTH, D_MODEL, D_IN_PROJ), D_MODEL ** -0.5),
        'conv_w': nrm(ks[3], (DEPTH, SHORT_CONV, D_HYENA_PROJ), SHORT_CONV ** -0.5),
        'conv_b': nrm(ks[4], (DEPTH, D_HYENA_PROJ), 0.01),
        'filt_w1': nrm(ks[5], (DEPTH, FILTER_EMB, FILTER_HIDDEN), FILTER_EMB ** -0.5),
        'filt_b1': nrm(ks[6], (DEPTH, FILTER_HIDDEN), 0.1),
        'filt_w2': nrm(ks[7], (DEPTH, FILTER_HIDDEN, FILTER_HIDDEN), FILTER_HIDDEN ** -0.5),
        'filt_b2': nrm(ks[8], (DEPTH, FILTER_HIDDEN), 0.1),
        'filt_w3': nrm(ks[9], (DEPTH, FILTER_HIDDEN, 2 * HYENA_ORDER * D_HYENA), 0.02),
        'filt_freq': 1.0 + nrm(ks[10], (DEPTH, FILTER_HIDDEN), 0.01),
        'filt_skip': nrm(ks[11], (DEPTH, HYENA_ORDER, D_HYENA), 1.0),
        'hyena_norm': 1.0 + nrm(ks[12], (DEPTH, D_HYENA), 0.01),
        'lb_fwd': nrm(ks[13], (DEPTH + 1, D_HGRN), 0.1),
        'lb_bwd': nrm(ks[14], (DEPTH + 1, D_HGRN), 0.1),
        'hgrn_norm': 1.0 + nrm(ks[15], (DEPTH, D_HGRN), 0.01),
        'w_out': nrm(ks[16], (DEPTH, D_MIX, D_MODEL), D_MIX ** -0.5),
        'norm_mix': 1.0 + nrm(ks[17], (DEPTH, D_MODEL), 0.01),
        'norm_ffn': 1.0 + nrm(ks[18], (DEPTH, D_MODEL), 0.01),
        'w_router_group': nrm(ks[19], (DEPTH, D_MODEL, N_GROUPS), D_MODEL ** -0.5),
        'w_router_expert': nrm(ks[20], (DEPTH, D_MODEL, N_GROUPS, EXPERTS_PER_GROUP), D_MODEL ** -0.5),
        'w_gate': nrm(ks[21], (DEPTH, N_EXPERTS, D_MODEL, D_EXPERT), D_MODEL ** -0.5),
        'w_up': nrm(ks[22], (DEPTH, N_EXPERTS, D_MODEL, D_EXPERT), D_MODEL ** -0.5),
        'w_down': nrm(ks[23], (DEPTH, N_EXPERTS, D_EXPERT, D_MODEL), D_EXPERT ** -0.5),
        'norm_final': 1.0 + nrm(ks[24], (D_MODEL,), 0.01),
    }


def reference(x, meta_tokens, w_in, conv_w, conv_b, filt_w1, filt_b1, filt_w2, filt_b2, filt_w3,
              filt_freq, filt_skip, hyena_norm, lb_fwd, lb_bwd, hgrn_norm, w_out, norm_mix, norm_ffn,
              w_router_group, w_router_expert, w_gate, w_up, w_down, norm_final):
    B = x.shape[0]
    meta = jnp.broadcast_to(meta_tokens[None].astype(x.dtype), (B, N_META, x.shape[-1]))
    h = jnp.concatenate([meta, x], axis=1)
    lbf_all = jnp.cumsum(jax.nn.softmax(lb_fwd.astype(jnp.float32), axis=0), axis=0)
    lbb_all = jnp.cumsum(jax.nn.softmax(lb_bwd.astype(jnp.float32), axis=0), axis=0)
    for l in range(DEPTH):
        a = rms_norm(h, norm_mix[l])
        p = a @ w_in[l]
        y_hy = hyena_mixer(p[..., :D_HYENA_PROJ], conv_w[l], conv_b[l], filt_w1[l], filt_b1[l],
                           filt_w2[l], filt_b2[l], filt_w3[l], filt_freq[l], filt_skip[l])
        y_hy = rms_norm(y_hy, hyena_norm[l])
        y_hg = hgrn2_mixer(p[..., D_HYENA_PROJ:], lbf_all[l], lbb_all[l], hgrn_norm[l])
        h = h + jnp.concatenate([y_hy, y_hg], axis=-1) @ w_out[l]
        h = h + hier_moe(rms_norm(h, norm_ffn[l]), w_router_group[l], w_router_expert[l],
                         w_gate[l], w_up[l], w_down[l])
    h = rms_norm(h, norm_final)
    return h[:, N_META:]
```

```cpp
#include <hip/hip_runtime.h>
#include <stdint.h>
#include <stdio.h>

namespace {
typedef unsigned short bf16;
constexpr int D = 1024, BATCH = 16, SEQ = 2048, NMETA = 16, L = SEQ + NMETA;
constexpr int NTOK = BATCH * L;
constexpr int NX = BATCH * SEQ;
constexpr int DH = 512, DG = 512, NHY = 1536, NHG = 2560, NPROJ = 4096;
constexpr int LP = 2080;
constexpr int GL = 4160;
constexpr int NE = 64, DE = 512;
constexpr int MAXSLOT = NX * 2 + NE * 256;
constexpr float EPS = 1e-6f;

__device__ __forceinline__ bf16 f2bf(float f) { unsigned u = __float_as_uint(f); u += 0x7FFFu + ((u >> 16) & 1u); return (bf16)(u >> 16); }
__device__ __forceinline__ float bf2f(bf16 b) { return __uint_as_float(((unsigned)b) << 16); }
__device__ __forceinline__ float wave_sum(float v) {
#pragma unroll
    for (int o = 32; o >= 1; o >>= 1) v += __shfl_xor(v, o);
    return v;
}
__device__ __forceinline__ float sigmoidf_(float x) { return 1.0f / (1.0f + __expf(-x)); }
__device__ __forceinline__ float siluf_(float x) { return x / (1.0f + __expf(-x)); }

struct P {
    const float *x, *meta, *w_in, *conv_w, *conv_b, *fw1, *fb1, *fw2, *fb2, *fw3, *ffreq, *fskip, *hy_norm, *lb_f, *lb_b, *hg_norm,
        *w_out, *norm_mix, *norm_ffn, *w_rg, *w_re, *w_gate, *w_up, *w_down, *norm_final;
    float* out;
    unsigned* bar;
    unsigned* cnt;
    bf16* A;
    bf16* pT;
    bf16* pg;
    float* G;
    bf16* z2;
    float* o;
    float* h1;
    float* rstd;
    int* list;
    int* asg_e;
    int* asg_rank;
    float* asg_gate;
    bf16* hid;
    bf16* y;
};

__device__ void ph_norm1(const P& p) {
    const int lane = threadIdx.x & 63, wpb = blockDim.x >> 6;
    const int wave = blockIdx.x * wpb + (threadIdx.x >> 6), nw = gridDim.x * wpb;
    for (int tok = wave; tok < NTOK; tok += nw) {
        const int b = tok / L, t = tok % L;
        const float* src = t < NMETA ? p.meta + (size_t)t * D : p.x + ((size_t)b * SEQ + (t - NMETA)) * D;
        float4 v[4]; float ss = 0.f;
#pragma unroll
        for (int i = 0; i < 4; ++i) { v[i] = ((const float4*)src)[i * 64 + lane]; ss += v[i].x * v[i].x + v[i].y * v[i].y + v[i].z * v[i].z + v[i].w * v[i].w; }
        ss = wave_sum(ss);
        const float r = rsqrtf(ss * (1.0f / D) + EPS);
#pragma unroll
        for (int i = 0; i < 4; ++i) {
            const float4 g = ((const float4*)p.norm_mix)[i * 64 + lane];
            ushort4 o; o.x = f2bf(v[i].x * r * g.x); o.y = f2bf(v[i].y * r * g.y); o.z = f2bf(v[i].z * r * g.z); o.w = f2bf(v[i].w * r * g.w);
            ((ushort4*)(p.A + (size_t)tok * D))[i * 64 + lane] = o;
        }
    }
}

__device__ void ph_filters(const P& p, float* sm) {
    float* z = sm; float* h1 = sm + 64; float* h2 = sm + 128;
    const int tid = threadIdx.x;
    for (int j = blockIdx.x; j < L; j += gridDim.x) {
        const double tj = (double)j / (double)(L - 1);
        if (tid < 33) {
            float v;
            if (tid == 0) v = (float)tj;
            else {
                const int i = (tid - 1) & 15;
                const double band = 1e-4 + (double)i * ((double)(15) - 1e-4) / 15.0;
                const double ang = (2.0 * 3.14159265358979323846 / (double)L) * (double)j * band;
                v = tid <= 16 ? (float)cos(ang) : (float)(-sin(ang));
            }
            z[tid] = v;
        }
        __syncthreads();
        if (tid < 64) { float a = p.fb1[tid]; for (int i = 0; i < 33; ++i) a += z[i] * p.fw1[i * 64 + tid]; h1[tid] = sinf(p.ffreq[tid] * a); }
        __syncthreads();
        if (tid < 64) { float a = p.fb2[tid]; for (int i = 0; i < 64; ++i) a += h1[i] * p.fw2[i * 64 + tid]; h2[tid] = sinf(p.ffreq[tid] * a); }
        __syncthreads();
        for (int n = tid; n < 2048; n += blockDim.x) {
            float a = 0.f; for (int i = 0; i < 64; ++i) a += h2[i] * p.fw3[i * 2048 + n];
            const int dir = n >> 10, order = (n >> 9) & 1, c = n & 511;
            const double lo = log(1e-2) / 1.5, hi = log(1e-2) / 0.3;
            const double delta = fabs(lo + (hi - lo) * (double)c / 511.0);
            a *= (float)exp(-tj * delta);
            float* g = p.G + ((size_t)order * 512 + c) * GL;
            if (dir == 0) g[L - 1 - j] = a; else if (j >= 1) g[L - 1 + j] = a;
        }
        __syncthreads();
    }
    for (int i = blockIdx.x * blockDim.x + tid; i < 1024 * (GL - (2 * L - 1)); i += gridDim.x * blockDim.x) {
        const int row = i / (GL - (2 * L - 1)), m = (2 * L - 1) + i % (GL - (2 * L - 1));
        p.G[(size_t)row * GL + m] = 0.f;
    }
}

template <bool DUAL, class AF, class BF, class EF>
__device__ __forceinline__ void gemm_tile64(int K, AF aload, BF bload, EF epi, float* sm) {
    float (*As)[68] = (float (*)[68])sm; float (*Bs)[68] = (float (*)[68])(sm + 16 * 68); float (*Bs2)[68] = (float (*)[68])(sm + 32 * 68);
    const int tid = threadIdx.x, ty = tid >> 4, tx = tid & 15;
    float acc[4][4], acc2[4][4];
#pragma unroll
    for (int i = 0; i < 4; ++i)
#pragma unroll
        for (int j = 0; j < 4; ++j) { acc[i][j] = 0.f; acc2[i][j] = 0.f; }
    const int ar = tid >> 2, ak = (tid & 3) * 4, bk = tid >> 4, bn = (tid & 15) * 4;
    for (int k0 = 0; k0 < K; k0 += 16) {
        const float4 a4 = aload(ar, k0 + ak); const float4 b4 = bload(k0 + bk, bn, 0); float4 c4 = make_float4(0, 0, 0, 0);
        if (DUAL) c4 = bload(k0 + bk, bn, 1);
        __syncthreads();
        As[ak + 0][ar] = a4.x; As[ak + 1][ar] = a4.y; As[ak + 2][ar] = a4.z; As[ak + 3][ar] = a4.w;
        *(float4*)&Bs[bk][bn] = b4; if (DUAL) *(float4*)&Bs2[bk][bn] = c4;
        __syncthreads();
#pragma unroll
        for (int kk = 0; kk < 16; ++kk) {
            const float4 a = *(const float4*)&As[kk][ty * 4]; const float4 b = *(const float4*)&Bs[kk][tx * 4];
            const float av[4] = {a.x, a.y, a.z, a.w}, bv[4] = {b.x, b.y, b.z, b.w};
#pragma unroll
            for (int i = 0; i < 4; ++i)
#pragma unroll
                for (int j = 0; j < 4; ++j) acc[i][j] += av[i] * bv[j];
            if (DUAL) { const float4 c = *(const float4*)&Bs2[kk][tx * 4]; const float cv[4] = {c.x, c.y, c.z, c.w};
#pragma unroll
                for (int i = 0; i < 4; ++i)
#pragma unroll
                    for (int j = 0; j < 4; ++j) acc2[i][j] += av[i] * cv[j]; }
        }
    }
#pragma unroll
    for (int i = 0; i < 4; ++i) epi(ty * 4 + i, tx * 4, acc[i], acc2[i]);
}
__device__ __forceinline__ float4 ld_bf4(const bf16* p) { const ushort4 u = *(const ushort4*)p; return make_float4(bf2f(u.x), bf2f(u.y), bf2f(u.z), bf2f(u.w)); }

__device__ void ph_inproj(const P& p, float* sm) {
    constexpr int TM = NTOK / 64, TN = NPROJ / 64;
    for (int u = blockIdx.x; u < TM * TN; u += gridDim.x) {
        const int tm = u / TN, tn = u % TN, row0 = tm * 64, col0 = tn * 64;
        gemm_tile64<false>(D,
            [&](int r, int k) { return ld_bf4(p.A + (size_t)(row0 + r) * D + k); },
            [&](int k, int n, int) { return *(const float4*)(p.w_in + (size_t)k * NPROJ + col0 + n); },
            [&](int r, int n, const float* a, const float*) {
                const int row = row0 + r, col = col0 + n, b = row / L, t = row % L;
                if (col < NHY) {
#pragma unroll
                    for (int j = 0; j < 4; ++j) p.pT[((size_t)(col + j) * BATCH + b) * LP + t] = f2bf(a[j]);
                } else {
                    ushort4 o; o.x = f2bf(a[0]); o.y = f2bf(a[1]); o.z = f2bf(a[2]); o.w = f2bf(a[3]);
                    *(ushort4*)(p.pg + (size_t)row * NHG + (col - NHY)) = o;
                }
            }, sm);
    }
}

__device__ void ph_hyena(const P& p, float* sm) {
    float* uv = sm; float* ux1 = sm + LP; float* ux2 = sm + 2 * LP; float* z1 = sm + 3 * LP; float* g0 = sm + 4 * LP; float* g1 = g0 + GL;
    const int tid = threadIdx.x, nt = blockDim.x;
    for (int u = blockIdx.x; u < DH * BATCH; u += gridDim.x) {
        const int c = u / BATCH, b = u % BATCH;
        __syncthreads();
        for (int w = 0; w < 3; ++w) {
            const int col = w * DH + c; const bf16* src = p.pT + ((size_t)col * BATCH + b) * LP;
            const float w0 = p.conv_w[col], w1 = p.conv_w[NHY + col], w2 = p.conv_w[2 * NHY + col], bb = p.conv_b[col];
            float* dst = w == 0 ? uv : (w == 1 ? ux1 : ux2);
            for (int t = tid; t < L; t += nt) {
                const float pm = t > 0 ? bf2f(src[t - 1]) : 0.f, p0 = bf2f(src[t]), pp = t < L - 1 ? bf2f(src[t + 1]) : 0.f;
                dst[t] = bb + w0 * pm + w1 * p0 + w2 * pp;
            }
        }
        for (int m = tid; m < GL; m += nt) { g0[m] = p.G[(size_t)c * GL + m]; g1[m] = p.G[((size_t)512 + c) * GL + m]; }
        __syncthreads();
        const float sk0 = p.fskip[c], sk1 = p.fskip[DH + c];
        for (int t = tid; t < L; t += nt) {
            float a = 0.f; const float* g = g0 + (L - 1 - t);
            for (int s = 0; s < L; ++s) a += uv[s] * g[s];
            z1[t] = ux1[t] * (a + sk0 * uv[t]);
        }
        __syncthreads();
        bf16* dst = p.z2 + ((size_t)c * BATCH + b) * LP;
        for (int t = tid; t < L; t += nt) {
            float a = 0.f; const float* g = g1 + (L - 1 - t);
            for (int s = 0; s < L; ++s) a += z1[s] * g[s];
            dst[t] = f2bf(ux2[t] * (a + sk1 * z1[t]));
        }
    }
}

__device__ void ph_hgrn(const P& p, float* sm) {
    const int tid = threadIdx.x, sub = tid >> 7, d = tid & 127, nsub = blockDim.x >> 7;
    float4* sh = (float4*)sm + sub * 256;
    for (int u = blockIdx.x * nsub + sub; u < BATCH * 4 * 2; u += gridDim.x * nsub) {
        const int dir = u & 1, h = (u >> 1) & 3, b = u >> 3, col = h * 128 + d;
        float lb;
        { const float* lbp = dir ? p.lb_b : p.lb_f; const float a0 = lbp[col], a1 = lbp[DG + col], m = fmaxf(a0, a1); const float e0 = __expf(a0 - m), e1 = __expf(a1 - m); lb = e0 / (e0 + e1); }
        float S[128];
#pragma unroll
        for (int i = 0; i < 128; ++i) S[i] = 0.f;
        const int fo = dir ? 1024 : 512;
        int t = dir ? L - 1 : 0;
        const bf16* row = p.pg + (size_t)(b * L + t) * NHG;
        bf16 nq = row[col], nf = row[fo + col], nv = row[1536 + col];
        for (int step = 0; step < L; ++step) {
            const float q = bf2f(nq), fl = bf2f(nf), v = bf2f(nv);
            const int tcur = t;
            if (step + 1 < L) { t = dir ? t - 1 : t + 1; row = p.pg + (size_t)(b * L + t) * NHG; nq = row[col]; nf = row[fo + col]; nv = row[1536 + col]; }
            const float f = lb + (1.0f - lb) * sigmoidf_(fl);
            sh[(step & 1) * 128 + d] = make_float4(siluf_(q), 1.0f - f, f, 0.f);
            __syncthreads();
            float o = 0.f;
#pragma unroll
            for (int i = 0; i < 128; ++i) { const float4 e = sh[(step & 1) * 128 + i]; S[i] = e.z * S[i] + e.y * v; o += S[i] * e.x; }
            p.o[((size_t)dir * NTOK + (size_t)b * L + tcur) * DG + col] = o;
        }
        __syncthreads();
    }
}

__device__ void ph_buildA2(const P& p, float* sm) {
    const int tid = threadIdx.x, lane = tid & 63, wid = tid >> 6;
    for (int xr = blockIdx.x; xr < NX; xr += gridDim.x) {
        const int b = xr / SEQ, t = NMETA + xr % SEQ; const size_t tok = (size_t)b * L + t;
        const float v0 = bf2f(p.z2[((size_t)(tid * 2) * BATCH + b) * LP + t]), v1 = bf2f(p.z2[((size_t)(tid * 2 + 1) * BATCH + b) * LP + t]);
        float ss = wave_sum(v0 * v0 + v1 * v1);
        __syncthreads();
        if (lane == 0) sm[wid] = ss;
        __syncthreads();
        ss = sm[0] + sm[1] + sm[2] + sm[3];
        const float r = rsqrtf(ss * (1.0f / DH) + EPS);
        bf16* dst = p.A + (size_t)xr * D;
        *(ushort2*)(dst + tid * 2) = make_ushort2(f2bf(v0 * r * p.hy_norm[tid * 2]), f2bf(v1 * r * p.hy_norm[tid * 2 + 1]));
        const int c0 = tid * 2;
        const float2 of = *(const float2*)(p.o + tok * DG + c0), ob = *(const float2*)(p.o + ((size_t)NTOK + tok) * DG + c0);
        const float o0 = of.x + ob.x, o1 = of.y + ob.y;
        const float hs = wave_sum(o0 * o0 + o1 * o1);
        const float hr = rsqrtf(hs * (1.0f / 128.0f) + EPS);
        const float g0 = bf2f(p.pg[tok * NHG + 2048 + c0]), g1 = bf2f(p.pg[tok * NHG + 2048 + c0 + 1]);
        *(ushort2*)(dst + DH + c0) = make_ushort2(f2bf(o0 * hr * p.hg_norm[c0] * siluf_(g0)), f2bf(o1 * hr * p.hg_norm[c0 + 1] * siluf_(g1)));
    }
}

__device__ void ph_outproj(const P& p, float* sm) {
    constexpr int TM = NX / 64, TN = D / 64;
    for (int u = blockIdx.x; u < TM * TN; u += gridDim.x) {
        const int tm = u / TN, tn = u % TN, row0 = tm * 64, col0 = tn * 64;
        gemm_tile64<false>(D,
            [&](int r, int k) { return ld_bf4(p.A + (size_t)(row0 + r) * D + k); },
            [&](int k, int n, int) { return *(const float4*)(p.w_out + (size_t)k * D + col0 + n); },
            [&](int r, int n, const float* a, const float*) {
                const size_t off = (size_t)(row0 + r) * D + col0 + n; const float4 xv = *(const float4*)(p.x + off);
                *(float4*)(p.h1 + off) = make_float4(xv.x + a[0], xv.y + a[1], xv.z + a[2], xv.w + a[3]);
            }, sm);
    }
}

__device__ void ph_router(const P& p) {
    const int lane = threadIdx.x & 63, wpb = blockDim.x >> 6;
    const int wave = blockIdx.x * wpb + (threadIdx.x >> 6), nw = gridDim.x * wpb;
    for (int xr = wave; xr < NX; xr += nw) {
        float hn[16]; float ss = 0.f;
#pragma unroll
        for (int i = 0; i < 4; ++i) {
            const float4 v = ((const float4*)(p.h1 + (size_t)xr * D))[i * 64 + lane]; const float4 g = ((const float4*)p.norm_ffn)[i * 64 + lane];
            ss += v.x * v.x + v.y * v.y + v.z * v.z + v.w * v.w;
            hn[i * 4 + 0] = v.x * g.x; hn[i * 4 + 1] = v.y * g.y; hn[i * 4 + 2] = v.z * g.z; hn[i * 4 + 3] = v.w * g.w;
            ushort4 o; o.x = f2bf(hn[i * 4 + 0]); o.y = f2bf(hn[i * 4 + 1]); o.z = f2bf(hn[i * 4 + 2]); o.w = f2bf(hn[i * 4 + 3]);
            ((ushort4*)(p.A + (size_t)xr * D))[i * 64 + lane] = o;
        }
        ss = wave_sum(ss);
        const float r = rsqrtf(ss * (1.0f / D) + EPS);
        float lg[8];
#pragma unroll
        for (int g = 0; g < 8; ++g) lg[g] = 0.f;
#pragma unroll
        for (int i = 0; i < 4; ++i)
#pragma unroll
            for (int j = 0; j < 4; ++j) {
                const int k = (i * 64 + lane) * 4 + j; const float4 w0 = *(const float4*)(p.w_rg + (size_t)k * 8), w1 = *(const float4*)(p.w_rg + (size_t)k * 8 + 4);
                const float h = hn[i * 4 + j];
                lg[0] += h * w0.x; lg[1] += h * w0.y; lg[2] += h * w0.z; lg[3] += h * w0.w; lg[4] += h * w1.x; lg[5] += h * w1.y; lg[6] += h * w1.z; lg[7] += h * w1.w;
            }
#pragma unroll
        for (int g = 0; g < 8; ++g) lg[g] = wave_sum(lg[g]) * r;
        int gs = 0; float best = lg[0];
#pragma unroll
        for (int g = 1; g < 8; ++g) if (lg[g] > best) { best = lg[g]; gs = g; }
        float den = 0.f;
#pragma unroll
        for (int g = 0; g < 8; ++g) den += __expf(lg[g] - best);
        const float pgroup = 1.0f / den;
        float le[8];
#pragma unroll
        for (int e = 0; e < 8; ++e) le[e] = 0.f;
#pragma unroll
        for (int i = 0; i < 4; ++i)
#pragma unroll
            for (int j = 0; j < 4; ++j) {
                const int k = (i * 64 + lane) * 4 + j; const float4 w0 = *(const float4*)(p.w_re + (size_t)k * 64 + gs * 8), w1 = *(const float4*)(p.w_re + (size_t)k * 64 + gs * 8 + 4);
                const float h = hn[i * 4 + j];
                le[0] += h * w0.x; le[1] += h * w0.y; le[2] += h * w0.z; le[3] += h * w0.w; le[4] += h * w1.x; le[5] += h * w1.y; le[6] += h * w1.z; le[7] += h * w1.w;
            }
#pragma unroll
        for (int e = 0; e < 8; ++e) le[e] = wave_sum(le[e]) * r;
        int e0 = 0; float b0 = le[0];
#pragma unroll
        for (int e = 1; e < 8; ++e) if (le[e] > b0) { b0 = le[e]; e0 = e; }
        int e1 = -1; float b1 = -3.0e38f;
#pragma unroll
        for (int e = 0; e < 8; ++e) if (e != e0 && le[e] > b1) { b1 = le[e]; e1 = e; }
        const float q1 = __expf(b1 - b0), inv = 1.0f / (1.0f + q1);
        if (lane == 0) {
            p.rstd[xr] = r;
            const int x0 = gs * 8 + e0, x1 = gs * 8 + e1;
            const int r0 = (int)atomicAdd(p.cnt + x0, 1u), r1 = (int)atomicAdd(p.cnt + x1, 1u);
            p.list[(size_t)x0 * NX + r0] = xr; p.list[(size_t)x1 * NX + r1] = xr;
            p.asg_e[xr * 2] = x0; p.asg_e[xr * 2 + 1] = x1; p.asg_rank[xr * 2] = r0; p.asg_rank[xr * 2 + 1] = r1;
            p.asg_gate[xr * 2] = pgroup * inv; p.asg_gate[xr * 2 + 1] = pgroup * q1 * inv;
        }
    }
}

__device__ void moe_tables(const P& p, int* tcum, int* soff) {
    if (threadIdx.x == 0) {
        int a = 0, s = 0;
        for (int e = 0; e < NE; ++e) { const int c = (int)p.cnt[e]; tcum[e] = a; soff[e] = s; a += (c + 63) / 64; s += (c + 255) / 256 * 256; }
        tcum[NE] = a; soff[NE] = s;
    }
    __syncthreads();
}

__device__ void ph_moe1(const P& p, float* sm) {
    int* tcum = (int*)(sm + 48 * 68); int* soff = tcum + 72;
    moe_tables(p, tcum, soff);
    constexpr int TN = DE / 64;
    const int nunits = tcum[NE] * TN;
    for (int u = blockIdx.x; u < nunits; u += gridDim.x) {
        const int rt = u / TN, tn = u % TN; int e = 0;
        while (tcum[e + 1] <= rt) ++e;
        const int r0 = (rt - tcum[e]) * 64, cnt = (int)p.cnt[e], col0 = tn * 64, s0 = soff[e] + r0;
        const int* lst = p.list + (size_t)e * NX;
        const float* wg = p.w_gate + (size_t)e * D * DE; const float* wu = p.w_up + (size_t)e * D * DE;
        gemm_tile64<true>(D,
            [&](int r, int k) { const int xr = (r0 + r) < cnt ? lst[r0 + r] : 0; return ld_bf4(p.A + (size_t)xr * D + k); },
            [&](int k, int n, int w) { return *(const float4*)((w ? wu : wg) + (size_t)k * DE + col0 + n); },
            [&](int r, int n, const float* a, const float* c) {
                const int xr = (r0 + r) < cnt ? lst[r0 + r] : 0; const float rs = p.rstd[xr];
                ushort4 o; o.x = f2bf(siluf_(a[0] * rs) * (c[0] * rs)); o.y = f2bf(siluf_(a[1] * rs) * (c[1] * rs)); o.z = f2bf(siluf_(a[2] * rs) * (c[2] * rs)); o.w = f2bf(siluf_(a[3] * rs) * (c[3] * rs));
                *(ushort4*)(p.hid + (size_t)(s0 + r) * DE + col0 + n) = o;
            }, sm);
    }
}
__device__ void ph_moe2(const P& p, float* sm) {
    int* tcum = (int*)(sm + 48 * 68); int* soff = tcum + 72;
    moe_tables(p, tcum, soff);
    constexpr int TN = D / 64;
    const int nunits = tcum[NE] * TN;
    for (int u = blockIdx.x; u < nunits; u += gridDim.x) {
        const int rt = u / TN, tn = u % TN; int e = 0;
        while (tcum[e + 1] <= rt) ++e;
        const int r0 = (rt - tcum[e]) * 64, col0 = tn * 64, s0 = soff[e] + r0;
        const float* wd = p.w_down + (size_t)e * DE * D;
        gemm_tile64<false>(DE,
            [&](int r, int k) { return ld_bf4(p.hid + (size_t)(s0 + r) * DE + k); },
            [&](int k, int n, int) { return *(const float4*)(wd + (size_t)k * D + col0 + n); },
            [&](int r, int n, const float* a, const float*) {
                ushort4 o; o.x = f2bf(a[0]); o.y = f2bf(a[1]); o.z = f2bf(a[2]); o.w = f2bf(a[3]);
                *(ushort4*)(p.y + (size_t)(s0 + r) * D + col0 + n) = o;
            }, sm);
    }
}
__device__ void ph_final(const P& p, float* sm) {
    int* tcum = (int*)sm; int* soff = tcum + 72;
    moe_tables(p, tcum, soff);
    const int lane = threadIdx.x & 63, wpb = blockDim.x >> 6;
    const int wave = blockIdx.x * wpb + (threadIdx.x >> 6), nw = gridDim.x * wpb;
    for (int xr = wave; xr < NX; xr += nw) {
        const int s0 = soff[p.asg_e[xr * 2]] + p.asg_rank[xr * 2], s1 = soff[p.asg_e[xr * 2 + 1]] + p.asg_rank[xr * 2 + 1];
        const float g0 = p.asg_gate[xr * 2], g1 = p.asg_gate[xr * 2 + 1];
        float4 v[4]; float ss = 0.f;
#pragma unroll
        for (int i = 0; i < 4; ++i) {
            const float4 h = ((const float4*)(p.h1 + (size_t)xr * D))[i * 64 + lane];
            const float4 a = ld_bf4(p.y + (size_t)s0 * D + (i * 64 + lane) * 4), c = ld_bf4(p.y + (size_t)s1 * D + (i * 64 + lane) * 4);
            v[i] = make_float4(h.x + g0 * a.x + g1 * c.x, h.y + g0 * a.y + g1 * c.y, h.z + g0 * a.z + g1 * c.z, h.w + g0 * a.w + g1 * c.w);
            ss += v[i].x * v[i].x + v[i].y * v[i].y + v[i].z * v[i].z + v[i].w * v[i].w;
        }
        ss = wave_sum(ss);
        const float r = rsqrtf(ss * (1.0f / D) + EPS);
#pragma unroll
        for (int i = 0; i < 4; ++i) {
            const float4 g = ((const float4*)p.norm_final)[i * 64 + lane];
            ((float4*)(p.out + (size_t)xr * D))[i * 64 + lane] = make_float4(v[i].x * r * g.x, v[i].y * r * g.y, v[i].z * r * g.z, v[i].w * r * g.w);
        }
    }
}

constexpr int SMEM_FLOATS = 4 * LP + 2 * GL;

template <int PH> __global__ void __launch_bounds__(256) k_phase(P p) {
    extern __shared__ float sm[];
    if (PH == 0) ph_norm1(p);
    if (PH == 1) ph_filters(p, sm);
    if (PH == 2) ph_inproj(p, sm);
    if (PH == 3) ph_hyena(p, sm);
    if (PH == 4) ph_hgrn(p, sm);
    if (PH == 5) ph_buildA2(p, sm);
    if (PH == 6) ph_outproj(p, sm);
    if (PH == 7) ph_router(p);
    if (PH == 8) ph_moe1(p, sm);
    if (PH == 9) ph_moe2(p, sm);
    if (PH == 10) ph_final(p, sm);
}

struct Alloc { size_t off = 0; size_t take(size_t bytes) { const size_t o = off; off += (bytes + 255) & ~(size_t)255; return o; } };
}

extern "C" void kernel_launch(void* const* d_in, const int* in_sizes, int n_in, void* d_out, int out_size, void* d_ws, size_t ws_size, hipStream_t stream) {
    (void)in_sizes; (void)n_in; (void)out_size;
    char* ws = (char*)d_ws;
    P p{};
    const float** ins[] = {&p.x, &p.meta, &p.w_in, &p.conv_w, &p.conv_b, &p.fw1, &p.fb1, &p.fw2, &p.fb2, &p.fw3, &p.ffreq, &p.fskip, &p.hy_norm, &p.lb_f, &p.lb_b,
                           &p.hg_norm, &p.w_out, &p.norm_mix, &p.norm_ffn, &p.w_rg, &p.w_re, &p.w_gate, &p.w_up, &p.w_down, &p.norm_final};
    for (int i = 0; i < 25; ++i) *ins[i] = (const float*)d_in[i];
    p.out = (float*)d_out;
    Alloc a;
    const size_t o_zero = a.take(65536);
    const size_t o_A = a.take((size_t)NTOK * D * 2);
    const size_t o_Preg = a.off;
    const size_t o_pT = a.take((size_t)NHY * BATCH * LP * 2);
    const size_t o_pg = a.take((size_t)NTOK * NHG * 2);
    const size_t o_Hreg = a.off;
    const size_t o_z2 = a.take((size_t)DH * BATCH * LP * 2);
    const size_t o_o = a.take((size_t)2 * NTOK * DG * 4);
    const size_t o_G = a.take((size_t)1024 * GL * 4);
    const size_t o_list = a.take((size_t)NE * NX * 4);
    const size_t o_rstd = a.take((size_t)NX * 4);
    const size_t o_ae = a.take((size_t)NX * 2 * 4), o_ar = a.take((size_t)NX * 2 * 4), o_ag = a.take((size_t)NX * 2 * 4);
    const size_t o_hid = o_Preg, o_y = o_Preg + (((size_t)MAXSLOT * DE * 2 + 255) & ~(size_t)255);
    const size_t o_h1 = o_Hreg;
    if (a.off > ws_size || o_y + (size_t)MAXSLOT * D * 2 > o_Hreg || (size_t)NX * D * 4 > a.off - o_Hreg) { fprintf(stderr, "workspace too small: need %zu have %zu\n", a.off, ws_size); return; }
    p.bar = (unsigned*)(ws + o_zero); p.cnt = p.bar + 8192;
    p.A = (bf16*)(ws + o_A); p.pT = (bf16*)(ws + o_pT); p.pg = (bf16*)(ws + o_pg); p.G = (float*)(ws + o_G); p.z2 = (bf16*)(ws + o_z2); p.o = (float*)(ws + o_o);
    p.h1 = (float*)(ws + o_h1); p.rstd = (float*)(ws + o_rstd); p.list = (int*)(ws + o_list); p.asg_e = (int*)(ws + o_ae); p.asg_rank = (int*)(ws + o_ar); p.asg_gate = (float*)(ws + o_ag);
    p.hid = (bf16*)(ws + o_hid); p.y = (bf16*)(ws + o_y);
    hipMemsetAsync(ws + o_zero, 0, 65536, stream);
    const size_t smb = SMEM_FLOATS * sizeof(float);
    static bool attr = false;
    if (!attr) { hipFuncSetAttribute((const void*)k_phase<3>, hipFuncAttributeMaxDynamicSharedMemorySize, (int)smb); attr = true; }
    k_phase<0><<<2048, 256, 0, stream>>>(p);
    k_phase<1><<<L, 256, 1024, stream>>>(p);
    k_phase<2><<<(NTOK / 64) * (NPROJ / 64), 256, 48 * 68 * 4, stream>>>(p);
    k_phase<3><<<DH * BATCH, 256, smb, stream>>>(p);
    k_phase<4><<<64, 256, 8192, stream>>>(p);
    k_phase<5><<<4096, 256, 64, stream>>>(p);
    k_phase<6><<<(NX / 64) * (D / 64), 256, 48 * 68 * 4, stream>>>(p);
    k_phase<7><<<2048, 256, 0, stream>>>(p);
    k_phase<8><<<4096, 256, 48 * 68 * 4 + 1024, stream>>>(p);
    k_phase<9><<<4096, 256, 48 * 68 * 4 + 1024, stream>>>(p);
    k_phase<10><<<2048, 256, 1024, stream>>>(p);
}
```

```cpp
#include <hip/hip_runtime.h>
#include <stdint.h>
#include <stdio.h>

namespace {
typedef unsigned short bf16;
constexpr int D = 1024, BATCH = 16, SEQ = 2048, NMETA = 16, L = SEQ + NMETA;
constexpr int NTOK = BATCH * L;
constexpr int NX = BATCH * SEQ;
constexpr int DH = 512, DG = 512, NHY = 1536, NHG = 2560, NPROJ = 4096;
constexpr int LP = 2080;
constexpr int GL = 4160;
constexpr int NE = 64, DE = 512;
constexpr int MAXSLOT = NX * 2 + NE * 256;
constexpr float EPS = 1e-6f;

__device__ __forceinline__ bf16 f2bf(float f) { unsigned u = __float_as_uint(f); u += 0x7FFFu + ((u >> 16) & 1u); return (bf16)(u >> 16); }
__device__ __forceinline__ float bf2f(bf16 b) { return __uint_as_float(((unsigned)b) << 16); }
__device__ __forceinline__ float wave_sum(float v) {
#pragma unroll
    for (int o = 32; o >= 1; o >>= 1) v += __shfl_xor(v, o);
    return v;
}
__device__ __forceinline__ float sigmoidf_(float x) { return 1.0f / (1.0f + __expf(-x)); }
__device__ __forceinline__ float siluf_(float x) { return x * __builtin_amdgcn_rcpf(1.0f + __builtin_amdgcn_exp2f(-1.44269504f * x)); }

#define XB_TMO      128
#define XB_XCNT(j)  (256  + 64 * (j))
#define XB_XSUB(j)  (1280 + 64 * (j))
#define XB_XGEN(j)  (2304 + 64 * (j))
#define XB_TOP      3328
#define XB_TOPGEN   3392
#define XCD_BAR_WORDS 3456
#define XB_SPIN_CAP (1u << 21)
#define LAS __attribute__((address_space(3)))

__device__ __forceinline__ unsigned xb_ld(unsigned* p)              { return __hip_atomic_load(p, __ATOMIC_RELAXED, __HIP_MEMORY_SCOPE_AGENT); }
__device__ __forceinline__ unsigned xb_add(unsigned* p, unsigned v) { return __hip_atomic_fetch_add(p, v, __ATOMIC_RELAXED, __HIP_MEMORY_SCOPE_AGENT); }
__device__ __forceinline__ unsigned xb_xcc_id() { return (unsigned)__builtin_amdgcn_s_getreg((3 << 11) | 20) & 0xFu; }
#define XB_SPIN(cond, bar) do { unsigned _sp = 0; while (cond) { __builtin_amdgcn_s_sleep(1); \
    if ((++_sp & 255u) == 0u) { if (xb_ld(&(bar)[XB_TMO])) break; if (_sp > XB_SPIN_CAP) { atomicAdd(&(bar)[XB_TMO], 1u); break; } } } } while (0)

struct XcdBarrier {
    unsigned* bar; unsigned x;
    volatile LAS unsigned* st;
};

__device__ __forceinline__ XcdBarrier xcd_barrier_post(unsigned* bar, volatile LAS unsigned* st) {
    XcdBarrier b; b.bar = bar; b.x = xb_xcc_id(); b.st = st;
    if (threadIdx.x == 0) (void)xb_add(&bar[XB_XCNT(b.x)], 1u);
    return b;
}
__device__ __forceinline__ void xcd_barrier_complete(unsigned* bar, unsigned x, unsigned& nloc, unsigned& nx) {
    const unsigned G = gridDim.x * gridDim.y * gridDim.z;
    unsigned sum, cnt, mine, sp = 0u;
    for (;;) {
        sum = 0u; cnt = 0u; mine = 0u;
#pragma unroll
        for (unsigned j = 0; j < 16; ++j) { const unsigned c = xb_ld(&bar[XB_XCNT(j)]); sum += c; cnt += (c > 0u) ? 1u : 0u; mine = (j == x) ? c : mine; }
        if (sum == G) break;
        __builtin_amdgcn_s_sleep(1);
        if ((++sp & 255u) == 0u) { if (xb_ld(&bar[XB_TMO])) break; if (sp > XB_SPIN_CAP) { atomicAdd(&bar[XB_TMO], 1u); break; } }
    }
    nloc = mine > 0u ? mine : 1u; nx = cnt > 0u ? cnt : 1u;
}

__device__ __forceinline__ void xcd_barrier(const XcdBarrier& b) {
    asm volatile("s_waitcnt vmcnt(0)" ::: "memory");
    __syncthreads();
    if (threadIdx.x == 0) {
        unsigned* bar = b.bar;
        __builtin_amdgcn_s_waitcnt(0);
        unsigned nloc = b.st[0], nx = b.st[1];
        if (nloc == 0u) { xcd_barrier_complete(bar, b.x, nloc, nx); b.st[0] = nloc; b.st[1] = nx; }
        const unsigned old = xb_add(&bar[XB_XSUB(b.x)], 1u);
        const unsigned gen = old / nloc;
        if (old + 1u == (gen + 1u) * nloc) {
            __builtin_amdgcn_fence(__ATOMIC_RELEASE, "agent");
            asm volatile("s_waitcnt vmcnt(0)" ::: "memory");
            const unsigned og = xb_add(&bar[XB_TOP], 1u);
            const unsigned tg = og / nx;
            if (og + 1u == (tg + 1u) * nx) xb_add(&bar[XB_TOPGEN], 1u);
            else XB_SPIN(xb_ld(&bar[XB_TOPGEN]) == tg, bar);
            __builtin_amdgcn_fence(__ATOMIC_ACQUIRE, "agent");
            xb_add(&bar[XB_XGEN(b.x)], 1u);
            asm volatile("s_waitcnt vmcnt(0)" ::: "memory");
        } else {
            XB_SPIN(xb_ld(&bar[XB_XGEN(b.x)]) == gen, bar);
            __builtin_amdgcn_fence(__ATOMIC_ACQUIRE, "agent");
            asm volatile("s_waitcnt vmcnt(0)" ::: "memory");
        }
    }
    __syncthreads();
}


struct P {
    const float *x, *meta, *w_in, *conv_w, *conv_b, *fw1, *fb1, *fw2, *fb2, *fw3, *ffreq, *fskip, *hy_norm, *lb_f, *lb_b, *hg_norm,
        *w_out, *norm_mix, *norm_ffn, *w_rg, *w_re, *w_gate, *w_up, *w_down, *norm_final;
    float* out;
    unsigned* bar;
    unsigned* cnt;
    bf16* A;
    bf16* Am;
    bf16* pT;
    bf16* pg;
    bf16* G;
    bf16* z2;
    bf16* o;
    bf16* h1;
    float* rstd;
    int* list;
    float* rsl;
    int* asg_e;
    int* asg_rank;
    float* asg_gate;
    bf16* hid;
    bf16* y;
    bf16 *W1t, *W2t, *Wgu, *Wd;
    bf16* Wr;
};

__device__ __forceinline__ void ph_norm1(const P& p) {
    int tid_ = threadIdx.x; asm volatile("" : "+v"(tid_));
    const int lane = tid_ & 63, wpb = blockDim.x >> 6;
    const int wave = blockIdx.x * wpb + (tid_ >> 6), nw = gridDim.x * wpb;
    float4 gn[4];
#pragma unroll
    for (int i = 0; i < 4; ++i) gn[i] = ((const float4*)p.norm_mix)[i * 64 + lane];
    constexpr int NR = NX + NMETA;
    for (int tok = wave; tok < NR; tok += 2 * nw) {
        const int tk[2] = {tok, tok + nw < NR ? tok + nw : tok};
        float4 v[2][4]; float ss[2];
#pragma unroll
        for (int q = 0; q < 2; ++q) {
            const float* src = tk[q] >= NX ? p.meta + (size_t)(tk[q] - NX) * D : p.x + (size_t)tk[q] * D;
#pragma unroll
            for (int i = 0; i < 4; ++i) v[q][i] = ((const float4*)src)[i * 64 + lane];
        }
#pragma unroll
        for (int q = 0; q < 2; ++q) { float s = 0.f;
#pragma unroll
            for (int i = 0; i < 4; ++i) s += v[q][i].x * v[q][i].x + v[q][i].y * v[q][i].y + v[q][i].z * v[q][i].z + v[q][i].w * v[q][i].w;
            ss[q] = wave_sum(s); }
#pragma unroll
        for (int q = 0; q < 2; ++q) {
            const float r = rsqrtf(ss[q] * (1.0f / D) + EPS);
            bf16* dst = tk[q] >= NX ? p.Am + (size_t)(tk[q] - NX) * D : p.A + (size_t)tk[q] * D;
#pragma unroll
            for (int i = 0; i < 4; ++i) {
                ushort4 o; o.x = f2bf(v[q][i].x * r * gn[i].x); o.y = f2bf(v[q][i].y * r * gn[i].y); o.z = f2bf(v[q][i].z * r * gn[i].z); o.w = f2bf(v[q][i].w * r * gn[i].w);
                ((ushort4*)dst)[i * 64 + lane] = o;
            }
        }
    }
}

typedef short bf16x8 __attribute__((ext_vector_type(8)));
typedef float f32x4 __attribute__((ext_vector_type(4)));
typedef unsigned u32x4 __attribute__((ext_vector_type(4)));
typedef unsigned u32x2 __attribute__((ext_vector_type(2)));
constexpr int BM = 256, BK = 64, HALF = 128, HTB = HALF * BK * 2, STAGE_BYTES = 8 * HTB;
__device__ __forceinline__ int lds_byte(int r, int c) { const int st = (r >> 4) * 2 + (c >> 5), rr = r & 15, cc = c & 31, ob = rr * 64 + cc * 2; return st * 1024 + (ob ^ (((ob >> 9) & 1) << 5)); }
__device__ __forceinline__ void stage_rc(int b, int& R, int& C) { const int st = b / 1024, sb = b % 1024, swz = sb ^ (((sb >> 9) & 1) << 5); R = (st >> 1) * 16 + swz / 64; C = (st & 1) * 32 + (swz % 64) / 2; }
__device__ __forceinline__ unsigned cvt_pk_bf16(float lo, float hi) { unsigned r; asm volatile("v_cvt_pk_bf16_f32 %0, %1, %2" : "=v"(r) : "v"(lo), "v"(hi)); return r; }

__device__ __forceinline__ float4 ld_bf4(const bf16* p) { const ushort4 u = *(const ushort4*)p; return make_float4(bf2f(u.x), bf2f(u.y), bf2f(u.z), bf2f(u.w)); }
__device__ __forceinline__ size_t blk16(int r, int c, int ncb) { return ((size_t)(r >> 4) * ncb + (c >> 4)) * 256 + (r & 15) * 16 + (c & 15); }
struct Unit { int pm, pn, e, r0; };
struct StaticOrder {
    int nM, nN, nwg, G, c;
    __device__ void init(int nM_, int nN_, int G_, int c_) { nM = nM_; nN = nN_; nwg = nM * nN; G = G_; c = c_; }
    __device__ bool next(int i, Unit& u) const {
        const long Lx = (long)i * G + c; if (Lx >= nwg) return false;
        int wgid = (int)Lx; { const int q = nwg / 8, r = nwg % 8, xcd = wgid % 8, off = wgid / 8; wgid = (xcd < r ? xcd * (q + 1) : r * (q + 1) + (xcd - r) * q) + off; }
        const int nig = 8 * nN, gid = wgid / nig, fm = gid * 8, gsz = (nM - fm) < 8 ? (nM - fm) : 8;
        u.pm = fm + ((wgid % nig) % gsz); u.pn = (wgid % nig) / gsz; u.e = 0; u.r0 = 0; return true;
    }
};

template <class GC, class Sched, class Epi>
__device__ __forceinline__ void gemm_phase(LAS unsigned char* lds, const GC& g, const Sched& S, const Epi& E) {
    int tid_ = threadIdx.x; asm volatile("" : "+v"(tid_));
    const int tid = tid_, wid = __builtin_amdgcn_readfirstlane(tid >> 6), lane = tid & 63, wr = wid >> 2, wc = wid & 3, fr = lane & 15, fq = lane >> 4;
    const int K = g.K, nt = K / BK;
    int Rr[2], Cc[2]; unsigned voffB[2];
#pragma unroll
    for (int i = 0; i < 2; ++i) { stage_rc(tid * 16 + i * 8192, Rr[i], Cc[i]); voffB[i] = (unsigned)(Rr[i] * K + Cc[i]) * 2u; }
    const size_t kstep = (size_t)(BK * 2), kstepA = (size_t)g.kstepA;
    const size_t hstepB = (size_t)HALF * K * 2;
    const unsigned ldsw = (unsigned)wid * 1024u;
    const int aoff = lds_byte(wr * 64 + fr, fq * 8), boff = lds_byte(wc * 32 + fr, fq * 8);
#define PG8_SA(b, h) (((b) * 2 + (h)) * HTB)
#define PG8_SB(b, h) ((4 + (b) * 2 + (h)) * HTB)
#define PG8_STAGE(bufoff, gbase, voff) do { _Pragma("unroll") for (int _i = 0; _i < 2; ++_i) \
        __builtin_amdgcn_global_load_lds((const unsigned*)((const char*)(gbase) + (voff)[_i]), (LAS unsigned*)(lds + (bufoff) + ldsw + _i * 8192), 16, 0, 0); } while (0)
#define PG8_LDA(dst, b, h) do { _Pragma("unroll") for (int m = 0; m < 4; ++m) _Pragma("unroll") for (int k = 0; k < 2; ++k) dst[m][k] = *(const LAS bf16x8*)(lds + PG8_SA(b, h) + aoff + m * 2048 + k * 1024); } while (0)
#define PG8_LDB(dst, b, h) do { _Pragma("unroll") for (int n = 0; n < 2; ++n) _Pragma("unroll") for (int k = 0; k < 2; ++k) dst[n][k] = *(const LAS bf16x8*)(lds + PG8_SB(b, h) + boff + n * 2048 + k * 1024); } while (0)
#define PG8_MMA(ai, bj, At, Bt) do { __builtin_amdgcn_s_setprio(1); _Pragma("unroll") for (int m = 0; m < 4; ++m) _Pragma("unroll") for (int n = 0; n < 2; ++n) _Pragma("unroll") for (int k = 0; k < 2; ++k) \
        acc[ai][bj][m][n] = __builtin_amdgcn_mfma_f32_16x16x32_bf16(Bt[n][k], At[m][k], acc[ai][bj][m][n], 0, 0, 0); __builtin_amdgcn_s_setprio(0); } while (0)
#define PG8_WAIT_V(n) asm volatile("s_waitcnt vmcnt(" #n ")" ::: "memory")
#define PG8_WAIT_L(n) asm volatile("s_waitcnt lgkmcnt(" #n ")" ::: "memory")
#define PG8_BAR __builtin_amdgcn_s_barrier()
#define PG8_SCHED __builtin_amdgcn_sched_barrier(0)
    Unit cur, nxt; int ui = 0;
    if (!S.next(0, cur)) return;
    f32x4 acc[2][2][4][2];
#pragma unroll
    for (int a = 0; a < 2; ++a)
#pragma unroll
        for (int b = 0; b < 2; ++b)
#pragma unroll
            for (int m = 0; m < 4; ++m)
#pragma unroll
                for (int n = 0; n < 2; ++n) acc[a][b][m][n] = (f32x4){0.f, 0.f, 0.f, 0.f};
    bf16x8 At[4][2], B0[2][2], B1[2][2];
    unsigned ca[2][2], na[2][2];
#pragma unroll
    for (int h = 0; h < 2; ++h)
#pragma unroll
        for (int i = 0; i < 2; ++i) ca[h][i] = g.aoff(cur, h * HALF + Rr[i], Cc[i]);
    const char* const A0 = g.A;
    const char* cB = g.bptr(cur);
    PG8_STAGE(PG8_SB(0, 0), cB, voffB); PG8_STAGE(PG8_SA(0, 0), A0, ca[0]); PG8_STAGE(PG8_SB(0, 1), cB + hstepB, voffB); PG8_STAGE(PG8_SA(0, 1), A0, ca[1]);
    if (wr == 1) PG8_BAR;
    PG8_WAIT_V(4); PG8_BAR;
    PG8_STAGE(PG8_SB(1, 0), cB + kstep, voffB); PG8_STAGE(PG8_SA(1, 0), A0 + kstepA, ca[0]); PG8_STAGE(PG8_SB(1, 1), cB + hstepB + kstep, voffB);
    PG8_WAIT_V(6); PG8_BAR;
    for (;;) {
        const bool has_next = S.next(ui + 1, nxt);
        const char* nB = cB;
#pragma unroll
        for (int h = 0; h < 2; ++h)
#pragma unroll
            for (int i = 0; i < 2; ++i) na[h][i] = ca[h][i];
        if (has_next) {
            nB = g.bptr(nxt);
#pragma unroll
            for (int h = 0; h < 2; ++h)
#pragma unroll
                for (int i = 0; i < 2; ++i) na[h][i] = g.aoff(nxt, h * HALF + Rr[i], Cc[i]);
        }
        for (int t = 0; t < nt; t += 2) {
            const bool last = (t == nt - 2);
            const char* a1 = A0 + (size_t)(t + 1) * kstepA;
            const char* a2 = last ? A0 : A0 + (size_t)(t + 2) * kstepA; const char* b2 = last ? nB : cB + (size_t)(t + 2) * kstep;
            const char* a3 = a2 + kstepA; const char* b3 = b2 + kstep;
            unsigned s0[2], s1[2];
            s0[0] = last ? na[0][0] : ca[0][0]; s0[1] = last ? na[0][1] : ca[0][1]; s1[0] = last ? na[1][0] : ca[1][0]; s1[1] = last ? na[1][1] : ca[1][1];
            PG8_LDB(B0, 0, 0); PG8_SCHED; PG8_LDA(At, 0, 0); PG8_STAGE(PG8_SA(1, 1), a1, ca[1]);
            PG8_WAIT_L(8); PG8_BAR; PG8_WAIT_L(0); PG8_MMA(0, 0, At, B0); PG8_BAR; PG8_SCHED;
            PG8_LDB(B1, 0, 1); PG8_STAGE(PG8_SB(0, 0), b2, voffB);
            PG8_BAR; PG8_WAIT_L(0); PG8_MMA(0, 1, At, B1); PG8_BAR;
            PG8_LDA(At, 0, 1); PG8_STAGE(PG8_SA(0, 0), a2, s0);
            PG8_BAR; PG8_WAIT_L(0); PG8_MMA(1, 0, At, B0); PG8_BAR; PG8_SCHED;
            PG8_STAGE(PG8_SB(0, 1), b2 + hstepB, voffB);
            PG8_WAIT_V(6); PG8_BAR; PG8_MMA(1, 1, At, B1); PG8_BAR;
            PG8_LDB(B0, 1, 0); PG8_SCHED; PG8_LDA(At, 1, 0); PG8_STAGE(PG8_SA(0, 1), a2, s1);
            PG8_WAIT_L(8); PG8_BAR; PG8_WAIT_L(0); PG8_MMA(0, 0, At, B0); PG8_BAR; PG8_SCHED;
            PG8_LDB(B1, 1, 1); PG8_STAGE(PG8_SB(1, 0), b3, voffB);
            PG8_BAR; PG8_WAIT_L(0); PG8_MMA(0, 1, At, B1); PG8_BAR;
            PG8_LDA(At, 1, 1); PG8_STAGE(PG8_SA(1, 0), a3, s0);
            PG8_BAR; PG8_WAIT_L(0); PG8_MMA(1, 0, At, B0); PG8_BAR; PG8_SCHED;
            PG8_STAGE(PG8_SB(1, 1), b3 + hstepB, voffB);
            PG8_WAIT_V(6); PG8_BAR; PG8_MMA(1, 1, At, B1); PG8_BAR;
        }
        E(acc, cur, wr, wc, fr, fq);
        if (!has_next) break;
#pragma unroll
        for (int a = 0; a < 2; ++a)
#pragma unroll
            for (int b = 0; b < 2; ++b)
#pragma unroll
                for (int m = 0; m < 4; ++m)
#pragma unroll
                    for (int n = 0; n < 2; ++n) acc[a][b][m][n] = (f32x4){0.f, 0.f, 0.f, 0.f};
        cur = nxt; cB = nB; ++ui;
#pragma unroll
        for (int h = 0; h < 2; ++h)
#pragma unroll
            for (int i = 0; i < 2; ++i) ca[h][i] = na[h][i];
    }
    PG8_WAIT_V(0);
    if (wr == 0) PG8_BAR;
    PG8_BAR;
#undef PG8_SA
#undef PG8_SB
#undef PG8_STAGE
#undef PG8_LDA
#undef PG8_LDB
#undef PG8_MMA
#undef PG8_WAIT_V
#undef PG8_WAIT_L
#undef PG8_BAR
#undef PG8_SCHED
}

template <class RM>
__device__ __forceinline__ void tconv_tile(const float* src, int ldn, int k0, int n0, bf16* dst, int ldd, RM rm, float* tile, const float* kscale = nullptr) {
    const int tid = threadIdx.x;
    __syncthreads();
    for (int idx = tid; idx < 1024; idx += blockDim.x) {
        const int kk = idx >> 4, nq = (idx & 15) * 4; float4 v = *(const float4*)(src + (size_t)(k0 + kk) * ldn + n0 + nq);
        if (kscale) { const float s = kscale[k0 + kk]; v.x *= s; v.y *= s; v.z *= s; v.w *= s; }
        float* tp = tile + kk * 65 + nq; tp[0] = v.x; tp[1] = v.y; tp[2] = v.z; tp[3] = v.w;
    }
    __syncthreads();
    { const int n = tid >> 3, kq = (tid & 7) * 8; const float* tp = tile + kq * 65 + n;
      uint4 o; o.x = cvt_pk_bf16(tp[0], tp[65]); o.y = cvt_pk_bf16(tp[130], tp[195]); o.z = cvt_pk_bf16(tp[260], tp[325]); o.w = cvt_pk_bf16(tp[390], tp[455]);
      *(uint4*)(dst + (size_t)rm(n0 + n) * ldd + k0 + kq) = o; }
}
struct CvDesc { const float* src; bf16* dst; int ldn, ldd, scale, k0; };
template <int MODE>
__device__ __forceinline__ CvDesc cv_decode(const P& p, int u) {
    CvDesc d;
    if (MODE == 1) {
        if (u < 512) { const int kt = u & 15, nt = u >> 4; d.src = p.w_in + (size_t)(kt * 64) * NPROJ + nt * 128; d.ldn = NPROJ; d.dst = p.W1t + (size_t)(nt * 128) * D + kt * 64; }
        else { const int q = u - 512, kt = q & 15, nt = q >> 4; d.src = p.w_out + (size_t)(kt * 64) * D + nt * 128; d.ldn = D; d.dst = p.W2t + (size_t)(nt * 128) * D + kt * 64; }
        d.ldd = D; d.scale = 0; d.k0 = 0; return d;
    }
    if (MODE == 0) { const int e = u >> 7, v = u & 127, w = v >> 6, q = v & 63, kt = q & 15, nt = q >> 4;
        d.src = (w ? p.w_up : p.w_gate) + (size_t)e * D * DE + (size_t)(kt * 64) * DE + nt * 128; d.ldn = DE; d.k0 = kt * 64; d.scale = 1;
        d.dst = p.Wgu + ((size_t)e * 1024 + nt * 256 + w * 128) * D + kt * 64; d.ldd = D; }
    else { const int e = u >> 6, q = u & 63, kt = q & 7, nt = q >> 3;
        d.src = p.w_down + (size_t)e * DE * D + (size_t)(kt * 64) * D + nt * 128; d.ldn = D; d.k0 = kt * 64; d.scale = 0;
        d.dst = p.Wd + ((size_t)e * 1024 + nt * 128) * DE + kt * 64; d.ldd = DE; }
    return d;
}
template <int MODE>
__device__ __forceinline__ void ph_conv(const P& p, float* tile, int it0, int it1) {
    int tid_ = threadIdx.x; asm volatile("" : "+v"(tid_));
    const int tid = tid_, total = MODE == 1 ? 640 : (MODE == 0 ? NE * 128 : NE * 64);
    float4 cur[4], nxt[4];
    int u = blockIdx.x + it0 * gridDim.x;
    const int uend = (long)blockIdx.x + (long)it1 * gridDim.x < total ? blockIdx.x + it1 * gridDim.x : total;
    CvDesc dc{};
    if (u < uend) { dc = cv_decode<MODE>(p, u);
#pragma unroll
        for (int q = 0; q < 4; ++q) { const int idx = tid + 512 * q, kk = idx >> 5, nq = (idx & 31) * 4; cur[q] = *(const float4*)(dc.src + (size_t)kk * dc.ldn + nq); } }
    for (; u < uend; u += gridDim.x) {
        const int un = u + gridDim.x; CvDesc dn = dc;
        if (un < uend) { dn = cv_decode<MODE>(p, un);
#pragma unroll
            for (int q = 0; q < 4; ++q) { const int idx = tid + 512 * q, kk = idx >> 5, nq = (idx & 31) * 4; nxt[q] = *(const float4*)(dn.src + (size_t)kk * dn.ldn + nq); } }
        __syncthreads();
#pragma unroll
        for (int q = 0; q < 4; ++q) { const int idx = tid + 512 * q, kk = idx >> 5, nq = (idx & 31) * 4; const float s = dc.scale ? p.norm_ffn[dc.k0 + kk] : 1.0f;
            float* tp = tile + kk * 129 + nq; tp[0] = cur[q].x * s; tp[1] = cur[q].y * s; tp[2] = cur[q].z * s; tp[3] = cur[q].w * s; }
        __syncthreads();
        { const int n = tid >> 2, kq = (tid & 3) * 16; const float* tp = tile + kq * 129 + n;
          u32x4 o0, o1;
          o0.x = cvt_pk_bf16(tp[0], tp[129]); o0.y = cvt_pk_bf16(tp[2 * 129], tp[3 * 129]); o0.z = cvt_pk_bf16(tp[4 * 129], tp[5 * 129]); o0.w = cvt_pk_bf16(tp[6 * 129], tp[7 * 129]);
          o1.x = cvt_pk_bf16(tp[8 * 129], tp[9 * 129]); o1.y = cvt_pk_bf16(tp[10 * 129], tp[11 * 129]); o1.z = cvt_pk_bf16(tp[12 * 129], tp[13 * 129]); o1.w = cvt_pk_bf16(tp[14 * 129], tp[15 * 129]);
          bf16* dp = dc.dst + (size_t)n * dc.ldd + kq; *(u32x4*)dp = o0; *(u32x4*)(dp + 8) = o1; }
        dc = dn;
#pragma unroll
        for (int q = 0; q < 4; ++q) cur[q] = nxt[q];
    }
    __syncthreads();
}

struct GIn { const char* A; int kstepA, K; const char* Bt;
    __device__ __forceinline__ unsigned aoff(const Unit& u, int r, int C) const { const int row = u.pm * BM + (u.pn < NHY / BM ? (r & ~63) + 4 * (r & 15) + ((r >> 4) & 3) : r); return (unsigned)row * (D * 2) + (unsigned)(C * 2); }
    __device__ __forceinline__ const char* bptr(const Unit& u) const { return Bt + (size_t)u.pn * BM * K * 2; } };
struct EpiIn { static constexpr int KIND = 1; bf16* pT; bf16* pg;
    __device__ __forceinline__ void operator()(const f32x4 (&acc)[2][2][4][2], const Unit& u, int wr, int wc, int fr, int fq) const {
        if (u.pn < NHY / BM) {
#pragma unroll
            for (int ai = 0; ai < 2; ++ai) { const int xr = u.pm * BM + ai * HALF + wr * 64 + 4 * fr, b = xr / SEQ, t = NMETA + xr % SEQ;
#pragma unroll
                for (int bj = 0; bj < 2; ++bj)
#pragma unroll
                    for (int n = 0; n < 2; ++n)
#pragma unroll
                        for (int j = 0; j < 4; ++j) { const int col = u.pn * BM + bj * HALF + wc * 32 + n * 16 + 4 * fq + j;
                            uint2 o; o.x = cvt_pk_bf16(acc[ai][bj][0][n][j], acc[ai][bj][1][n][j]); o.y = cvt_pk_bf16(acc[ai][bj][2][n][j], acc[ai][bj][3][n][j]);
                            *(uint2*)(pT + ((size_t)col * BATCH + b) * LP + t) = o; } }
        } else {
            const int act = 0;
#pragma unroll
            for (int ai = 0; ai < 2; ++ai)
#pragma unroll
                for (int m = 0; m < 4; ++m) { const int xr = u.pm * BM + ai * HALF + wr * 64 + m * 16 + fr; const int tok = (xr / SEQ) * L + NMETA + xr % SEQ;
#pragma unroll
                    for (int bj = 0; bj < 2; ++bj)
#pragma unroll
                        for (int n = 0; n < 2; ++n) { f32x4 v = acc[ai][bj][m][n];
                            if (act) {
#pragma unroll
                                for (int j = 0; j < 4; ++j) { const float sgm = __builtin_amdgcn_rcpf(1.0f + __builtin_amdgcn_exp2f(-1.44269504f * v[j])); v[j] = act == 1 ? v[j] * sgm : sgm; } }
                            uint2 o; o.x = cvt_pk_bf16(v[0], v[1]); o.y = cvt_pk_bf16(v[2], v[3]);
                            *(uint2*)(pg + blk16(tok, (u.pn * BM - NHY) + bj * HALF + wc * 32 + n * 16 + 4 * fq, NHG / 16)) = o; } }
        }
    } };
__device__ __forceinline__ void ph_inproj_meta(const P& p, LAS unsigned char* lds) {
    int tid_ = threadIdx.x; asm volatile("" : "+v"(tid_));
    const int tid = tid_, w = __builtin_amdgcn_readfirstlane(tid >> 6), lane = tid & 63, i = lane & 15, g = lane >> 4;
    LAS float* part = (LAS float*)lds;
    for (int ct = blockIdx.x; ct < NPROJ / 16; ct += gridDim.x) {
        __syncthreads();
        f32x4 acc = (f32x4){0.f, 0.f, 0.f, 0.f};
#pragma unroll
        for (int kk = 0; kk < 4; ++kk) {
            const int k = 128 * w + 32 * kk + 8 * g;
            const bf16x8 a = *(const bf16x8*)(p.W1t + (size_t)(16 * ct + i) * D + k), bb = *(const bf16x8*)(p.Am + (size_t)i * D + k);
            acc = __builtin_amdgcn_mfma_f32_16x16x32_bf16(a, bb, acc, 0, 0, 0);
        }
#pragma unroll
        for (int r = 0; r < 4; ++r) part[(w * 16 + 4 * g + r) * 17 + i] = acc[r];
        __syncthreads();
        if (tid < 256) {
            const int cl = tid >> 4, t = tid & 15, col = 16 * ct + cl; float v = 0.f;
#pragma unroll
            for (int ww = 0; ww < 8; ++ww) v += part[(ww * 16 + cl) * 17 + t];
            if (col < NHY) { const bf16 o = f2bf(v);
#pragma unroll
                for (int b = 0; b < BATCH; ++b) p.pT[((size_t)col * BATCH + b) * LP + t] = o; }
            else { const int act = 0;
                if (act) { const float sgm = __builtin_amdgcn_rcpf(1.0f + __builtin_amdgcn_exp2f(-1.44269504f * v)); v = act == 1 ? v * sgm : sgm; }
                const bf16 o = f2bf(v);
#pragma unroll
                for (int b = 0; b < BATCH; ++b) p.pg[blk16(b * L + t, col - NHY, NHG / 16)] = o; }
        }
    }
    __syncthreads();
}
__device__ __forceinline__ void ph_inproj(const P& p, LAS unsigned char* lds) {
    GIn g{(const char*)p.A, BK * 2, D, (const char*)p.W1t}; StaticOrder S; S.init(NX / BM, NPROJ / BM, gridDim.x, blockIdx.x); EpiIn E{p.pT, p.pg};
    gemm_phase(lds, g, S, E);
    ph_inproj_meta(p, lds);
}
struct GOut { const char* A; int kstepA, K; const char* Bt;
    __device__ __forceinline__ unsigned aoff(const Unit& u, int r, int C) const { return (unsigned)(u.pm * BM + r) * (D * 2) + (unsigned)(C * 2); }
    __device__ __forceinline__ const char* bptr(const Unit& u) const { return Bt + (size_t)u.pn * BM * K * 2; } };
struct EpiOut { static constexpr int KIND = 2; const float* x; bf16* h1;
    __device__ __forceinline__ void operator()(const f32x4 (&acc)[2][2][4][2], const Unit& u, int wr, int wc, int fr, int fq) const {
#pragma unroll
        for (int ai = 0; ai < 2; ++ai)
#pragma unroll
            for (int m = 0; m < 4; ++m) { const int row = u.pm * BM + ai * HALF + wr * 64 + m * 16 + fr, col0 = u.pn * BM + wc * 32 + 4 * fq;
#pragma unroll
                for (int bj = 0; bj < 2; ++bj)
#pragma unroll
                    for (int n = 0; n < 2; ++n) { const int col = col0 + bj * HALF + n * 16; const f32x4 v = *(const f32x4*)(x + (size_t)row * D + col) + acc[ai][bj][m][n];
                        u32x2 o; o.x = cvt_pk_bf16(v[0], v[1]); o.y = cvt_pk_bf16(v[2], v[3]); *(u32x2*)(h1 + (size_t)row * D + col) = o; } }
    } };
__device__ __forceinline__ void ph_outproj(const P& p, LAS unsigned char* lds) {
    GOut g{(const char*)p.A, BK * 2, D, (const char*)p.W2t}; StaticOrder S; S.init(NX / BM, D / BM, gridDim.x, blockIdx.x); EpiOut E{p.x, p.h1};
    gemm_phase(lds, g, S, E);
}

constexpr int ZS = 2088, ZSB = ZS * 2;
constexpr int HY_ZB = 0, HY_Z1 = 16 * ZSB, HY_G0 = 2 * 16 * ZSB, HY_G1 = HY_G0 + GL * 2, HY_END = HY_G1 + GL * 2;
typedef short bf16x8a __attribute__((ext_vector_type(8), aligned(4)));

__device__ __forceinline__ float bflo(unsigned u) { return __uint_as_float(u << 16); }
__device__ __forceinline__ float bfhi(unsigned u) { return __uint_as_float(u & 0xffff0000u); }

__device__ __forceinline__ void hy_load_conv(const P& p, int col, LAS unsigned char* dst) {
    const float w0 = p.conv_w[col], w1 = p.conv_w[NHY + col], w2 = p.conv_w[2 * NHY + col], bb = p.conv_b[col];
    for (int gi = threadIdx.x; gi < 16 * (ZS / 8); gi += blockDim.x) {
        const int b = gi / (ZS / 8), t0 = (gi % (ZS / 8)) * 8;
        u32x4 o = (u32x4){0u, 0u, 0u, 0u};
        if (t0 < L) {
            const bf16* src = p.pT + ((size_t)col * BATCH + b) * LP + t0;
            const u32x4 v = *(const u32x4*)src;
            float f[10];
            f[0] = t0 > 0 ? bf2f(src[-1]) : 0.f; f[9] = (t0 + 8 < L) ? bf2f(src[8]) : 0.f;
            f[1] = bflo(v.x); f[2] = bfhi(v.x); f[3] = bflo(v.y); f[4] = bfhi(v.y); f[5] = bflo(v.z); f[6] = bfhi(v.z); f[7] = bflo(v.w); f[8] = bfhi(v.w);
            float u[8];
#pragma unroll
            for (int j = 0; j < 8; ++j) u[j] = bb + w0 * f[j] + w1 * f[j + 1] + w2 * f[j + 2];
            o.x = cvt_pk_bf16(u[0], u[1]); o.y = cvt_pk_bf16(u[2], u[3]); o.z = cvt_pk_bf16(u[4], u[5]); o.w = cvt_pk_bf16(u[6], u[7]);
        }
        *(LAS u32x4*)(dst + b * ZSB + t0 * 2) = o;
    }
}
__device__ __forceinline__ void hy_load_taps(const P& p, int order, int c, LAS unsigned char* lds) {
    const bf16* src = p.G + ((size_t)order * 512 + c) * GL;
    for (int k = threadIdx.x; k < GL / 8; k += blockDim.x) {
        const u32x4 v = *(const u32x4*)(src + k * 8);
        const unsigned nx = (k * 8 + 8 < GL) ? (unsigned)src[k * 8 + 8] : 0u;
        *(LAS u32x4*)(lds + HY_G0 + k * 16) = v;
        u32x4 s; s.x = (v.x >> 16) | (v.y << 16); s.y = (v.y >> 16) | (v.z << 16); s.z = (v.z >> 16) | (v.w << 16); s.w = (v.w >> 16) | (nx << 16);
        *(LAS u32x4*)(lds + HY_G1 + k * 16) = s;
    }
}
template <int STAGE>
__device__ __forceinline__ void hy_stage(const P& p, LAS unsigned char* lds, int c, float skip) {
    int tid_ = threadIdx.x; asm volatile("" : "+v"(tid_));
    const int tid = tid_, w = __builtin_amdgcn_readfirstlane(tid >> 6), lane = tid & 63, i = lane & 15, g = lane >> 4;
    const int it0 = w * 17;
    const LAS unsigned char* zsrc = lds + (STAGE == 0 ? HY_ZB : HY_Z1) + i * ZSB + g * 16;
    const LAS unsigned char* gl0 = ((i & 1) ? lds + HY_G0 + 2 * (8 * g - i + L - 1) : lds + HY_G1 + 2 * (8 * g - i + L - 2)) - 32 * it0;
    f32x4 acc[17];
#pragma unroll
    for (int a = 0; a < 17; ++a) acc[a] = (f32x4){0.f, 0.f, 0.f, 0.f};
    bf16x8 R[20];
#pragma unroll
    for (int a = 0; a < 17; ++a) R[a] = *(const LAS bf16x8a*)(gl0 - 32 * a);
    bf16x8 Zc = *(const LAS bf16x8*)zsrc, Zn = Zc;
    const bool full = (w != 7);
#define HY_STEP(u, js, PF) do { \
        if (PF) { R[(40 - 2 * ((u) + 1)) % 20] = *(const LAS bf16x8a*)(gl0 + 64 * ((js) + 1)); R[(41 - 2 * ((u) + 1)) % 20] = *(const LAS bf16x8a*)(gl0 + 64 * ((js) + 1) - 32); \
                  Zn = *(const LAS bf16x8*)(zsrc + 64 * ((js) + 1)); } \
        _Pragma("unroll") for (int a = 0; a < 10; ++a) acc[a] = __builtin_amdgcn_mfma_f32_16x16x32_bf16(R[(a + 40 - 2 * (u)) % 20], Zc, acc[a], 0, 0, 0); \
        if (full) { _Pragma("unroll") for (int a = 10; a < 17; ++a) acc[a] = __builtin_amdgcn_mfma_f32_16x16x32_bf16(R[(a + 40 - 2 * (u)) % 20], Zc, acc[a], 0, 0, 0); } \
        Zc = Zn; } while (0)
    for (int jb = 0; jb < 60; jb += 10) {
#pragma unroll
        for (int u = 0; u < 10; ++u) HY_STEP(u, jb + u, true);
    }
#pragma unroll
    for (int u = 0; u < 5; ++u) HY_STEP(u, 60 + u, u < 4);
#undef HY_STEP
#pragma unroll
    for (int a = 0; a < 17; ++a) {
        const int it = it0 + a;
        if (it < 129) {
            const int t = 16 * it + 4 * g, ad = i * ZSB + t * 2;
            const u32x2 zv = *(const LAS u32x2*)(lds + HY_ZB + ad), z1v = *(const LAS u32x2*)(lds + HY_Z1 + ad);
            if (STAGE == 0) {
                u32x2 o;
                o.x = cvt_pk_bf16(bflo(z1v.x) * (acc[a][0] + skip * bflo(zv.x)), bfhi(z1v.x) * (acc[a][1] + skip * bfhi(zv.x)));
                o.y = cvt_pk_bf16(bflo(z1v.y) * (acc[a][2] + skip * bflo(zv.y)), bfhi(z1v.y) * (acc[a][3] + skip * bfhi(zv.y)));
                *(LAS u32x2*)(lds + HY_Z1 + ad) = o;
            } else {
                u32x2 o;
                o.x = cvt_pk_bf16(bflo(zv.x) * (acc[a][0] + skip * bflo(z1v.x)), bfhi(zv.x) * (acc[a][1] + skip * bfhi(z1v.x)));
                o.y = cvt_pk_bf16(bflo(zv.y) * (acc[a][2] + skip * bflo(z1v.y)), bfhi(zv.y) * (acc[a][3] + skip * bfhi(z1v.y)));
                *(u32x2*)(p.z2 + ((size_t)c * BATCH + i) * LP + t) = o;
            }
        }
    }
}
__device__ __forceinline__ void hyena_channel(const P& p, LAS unsigned char* lds, int c) {
    {
        __syncthreads();
        hy_load_conv(p, c, lds + HY_ZB); hy_load_conv(p, DH + c, lds + HY_Z1); hy_load_taps(p, 0, c, lds);
        __syncthreads();
        hy_stage<0>(p, lds, c, p.fskip[c]);
        __syncthreads();
        hy_load_conv(p, 2 * DH + c, lds + HY_ZB); hy_load_taps(p, 1, c, lds);
        __syncthreads();
        hy_stage<1>(p, lds, c, p.fskip[DH + c]);
    }
}

constexpr int HG_RS = 272, HG_RS64 = 144;
constexpr int HG_QS = 0, HG_KS = HG_QS + 64 * HG_RS, HG_KDT = HG_KS + 64 * HG_RS, HG_VT = HG_KDT + 128 * HG_RS64, HG_SC = HG_VT + 128 * HG_RS64, HG_ST = HG_SC + 64 * HG_RS64,
              HG_DEC = HG_ST + 128 * HG_RS, HG_EBM = HG_DEC + 128 * 4, HG_END = HG_EBM + 128 * 4;
__device__ __forceinline__ float dpp_add_(float v, const int ctrl_sel) {
    int t;
    const int iv = __float_as_int(v);
    if (ctrl_sel == 0) t = __builtin_amdgcn_update_dpp(0, iv, 0x111, 0xf, 0xf, false);
    else if (ctrl_sel == 1) t = __builtin_amdgcn_update_dpp(0, iv, 0x112, 0xf, 0xf, false);
    else if (ctrl_sel == 2) t = __builtin_amdgcn_update_dpp(0, iv, 0x114, 0xf, 0xf, false);
    else if (ctrl_sel == 3) t = __builtin_amdgcn_update_dpp(0, iv, 0x118, 0xf, 0xf, false);
    else if (ctrl_sel == 4) t = __builtin_amdgcn_update_dpp(0, iv, 0x142, 0xa, 0xf, false);
    else t = __builtin_amdgcn_update_dpp(0, iv, 0x143, 0xc, 0xf, false);
    return v + __int_as_float(t);
}
__device__ __forceinline__ float wave_incl_scan(float v) { v = dpp_add_(v, 0); v = dpp_add_(v, 1); v = dpp_add_(v, 2); v = dpp_add_(v, 3); v = dpp_add_(v, 4); v = dpp_add_(v, 5); return v; }
__device__ __forceinline__ float dpp_mul_(float v, const int ctrl_sel) {
    int t; const int iv = __float_as_int(v), one = 0x3f800000;
    if (ctrl_sel == 0) t = __builtin_amdgcn_update_dpp(one, iv, 0x111, 0xf, 0xf, false);
    else if (ctrl_sel == 1) t = __builtin_amdgcn_update_dpp(one, iv, 0x112, 0xf, 0xf, false);
    else if (ctrl_sel == 2) t = __builtin_amdgcn_update_dpp(one, iv, 0x114, 0xf, 0xf, false);
    else if (ctrl_sel == 3) t = __builtin_amdgcn_update_dpp(one, iv, 0x118, 0xf, 0xf, false);
    else if (ctrl_sel == 4) t = __builtin_amdgcn_update_dpp(one, iv, 0x142, 0xa, 0xf, false);
    else t = __builtin_amdgcn_update_dpp(one, iv, 0x143, 0xc, 0xf, false);
    return v * __int_as_float(t);
}
__device__ __forceinline__ float wave_incl_prod(float v) { v = dpp_mul_(v, 0); v = dpp_mul_(v, 1); v = dpp_mul_(v, 2); v = dpp_mul_(v, 3); v = dpp_mul_(v, 4); v = dpp_mul_(v, 5); return v; }
__device__ __forceinline__ float rdlane(float v, int l) { return __int_as_float(__builtin_amdgcn_readlane(__float_as_int(v), l)); }

__device__ __forceinline__ void hgrn_unit(const P& p, LAS unsigned char* lds, int u) {
    int tid_ = threadIdx.x; asm volatile("" : "+v"(tid_));
    const int tid = tid_, w = __builtin_amdgcn_readfirstlane(tid >> 6), lane = tid & 63, i = lane & 15, g = lane >> 4;
    {
        const int dir = u & 1, h = (u >> 1) & 3, b = u >> 3;
        float lbv[16];
#pragma unroll
        for (int dd = 0; dd < 16; ++dd) { const float* lbp = dir ? p.lb_b : p.lb_f; const float a0 = lbp[h * 128 + 16 * w + dd], a1 = lbp[DG + h * 128 + 16 * w + dd], mx = fmaxf(a0, a1);
            const float e0 = __expf(a0 - mx), e1 = __expf(a1 - mx); lbv[dd] = e0 / (e0 + e1); }
        const int tokb = b * L;
        const int qoff = h * 128 + 16 * w, foff = (dir ? 1024 : 512) + h * 128 + 16 * w, voff = 1536 + h * 128 + 16 * w;
        bf16* po = p.o + ((size_t)dir * NTOK + (size_t)b * L) * DG + h * 128;
        f32x4 S[8];
#pragma unroll
        for (int vi = 0; vi < 8; ++vi) S[vi] = (f32x4){0.f, 0.f, 0.f, 0.f};
        __syncthreads();
        u32x4 rq0, rq1, rf0, rf1, rv0, rv1;
#define HG_TOK(m, j) (dir ? 64 * (m) + 15 - (j) : 64 * (m) - 48 + (j))
#define HG_LOADRAW(m) do { const int t_ = HG_TOK(m, lane); rq0 = rq1 = rf0 = rf1 = rv0 = rv1 = (u32x4){0u, 0u, 0u, 0u}; \
            if (t_ >= 0) { const bf16* r_ = p.pg + blk16(tokb + t_, 0, NHG / 16); rq0 = *(const u32x4*)(r_ + (qoff >> 4) * 256); rq1 = *(const u32x4*)(r_ + (qoff >> 4) * 256 + 8); \
                           rf0 = *(const u32x4*)(r_ + (foff >> 4) * 256); rf1 = *(const u32x4*)(r_ + (foff >> 4) * 256 + 8); rv0 = *(const u32x4*)(r_ + (voff >> 4) * 256); rv1 = *(const u32x4*)(r_ + (voff >> 4) * 256 + 8); } } while (0)
        HG_LOADRAW(dir ? 32 : 0);
        for (int n = 0; n < 33; ++n) {
            const int m = dir ? 32 - n : n;
            {
                const bool valid = HG_TOK(m, lane) >= 0;
                const unsigned qw[8] = {rq0.x, rq0.y, rq0.z, rq0.w, rq1.x, rq1.y, rq1.z, rq1.w}, fw[8] = {rf0.x, rf0.y, rf0.z, rf0.w, rf1.x, rf1.y, rf1.z, rf1.w};
                float qsv[16], ksv[16]; float decv = 0.f;
#pragma unroll
                for (int dd = 0; dd < 16; ++dd) {
                    const float qr = (dd & 1) ? bfhi(qw[dd >> 1]) : bflo(qw[dd >> 1]), fr_ = (dd & 1) ? bfhi(fw[dd >> 1]) : bflo(fw[dd >> 1]);
                    const float qq = qr * __builtin_amdgcn_rcpf(1.0f + __builtin_amdgcn_exp2f(-1.44269504f * qr)), fl = __builtin_amdgcn_rcpf(1.0f + __builtin_amdgcn_exp2f(-1.44269504f * fr_));
                    const float f = valid ? lbv[dd] + (1.0f - lbv[dd]) * fl : 1.0f, k = 1.0f - f;
                    const float Pj = wave_incl_prod(f), P63 = rdlane(Pj, 63);
                    qsv[dd] = qq * Pj; ksv[dd] = k * __builtin_amdgcn_rcpf(Pj);
                    *(LAS bf16*)(lds + HG_KDT + (16 * w + dd) * HG_RS64 + lane * 2) = f2bf(ksv[dd] * P63);
                    decv = (lane == dd) ? P63 : decv;
                }
                u32x4 o0, o1;
#define HG_PK(arr, dst) o0.x = cvt_pk_bf16(arr[0], arr[1]); o0.y = cvt_pk_bf16(arr[2], arr[3]); o0.z = cvt_pk_bf16(arr[4], arr[5]); o0.w = cvt_pk_bf16(arr[6], arr[7]); \
                        o1.x = cvt_pk_bf16(arr[8], arr[9]); o1.y = cvt_pk_bf16(arr[10], arr[11]); o1.z = cvt_pk_bf16(arr[12], arr[13]); o1.w = cvt_pk_bf16(arr[14], arr[15]); \
                        *(LAS u32x4*)(lds + (dst) + lane * HG_RS + 32 * w) = o0; *(LAS u32x4*)(lds + (dst) + lane * HG_RS + 32 * w + 16) = o1;
                HG_PK(qsv, HG_QS) HG_PK(ksv, HG_KS)
#undef HG_PK
                if (lane < 16) *(LAS float*)(lds + HG_DEC + (16 * w + lane) * 4) = decv;
                const unsigned vw[8] = {rv0.x, rv0.y, rv0.z, rv0.w, rv1.x, rv1.y, rv1.z, rv1.w};
#pragma unroll
                for (int e = 0; e < 16; ++e) *(LAS bf16*)(lds + HG_VT + (16 * w + e) * HG_RS64 + lane * 2) = (bf16)((e & 1) ? (vw[e >> 1] >> 16) : (vw[e >> 1] & 0xffffu));
            }
            if (n + 1 < 33) { const int mn = dir ? 31 - n : n + 1; HG_LOADRAW(mn); }
            __syncthreads();
            {
#pragma unroll
                for (int vi = 0; vi < 8; ++vi) { const f32x4 sv = S[vi]; u32x2 o; o.x = cvt_pk_bf16(sv[0], sv[1]); o.y = cvt_pk_bf16(sv[2], sv[3]); *(LAS u32x2*)(lds + HG_ST + (16 * vi + i) * HG_RS + (16 * w + 4 * g) * 2) = o; }
            }
            {
                const int si = w >> 1, tp = (w & 1) * 2;
                f32x4 sa[2] = {(f32x4){0.f, 0.f, 0.f, 0.f}, (f32x4){0.f, 0.f, 0.f, 0.f}};
#pragma unroll
                for (int kk = 0; kk < 4; ++kk) {
                    const bf16x8 A = *(const LAS bf16x8*)(lds + HG_KS + (16 * si + i) * HG_RS + (32 * kk + 8 * g) * 2);
#pragma unroll
                    for (int q = 0; q < 2; ++q) { const bf16x8 B = *(const LAS bf16x8*)(lds + HG_QS + (16 * (tp + q) + i) * HG_RS + (32 * kk + 8 * g) * 2); sa[q] = __builtin_amdgcn_mfma_f32_16x16x32_bf16(A, B, sa[q], 0, 0, 0); }
                }
#pragma unroll
                for (int q = 0; q < 2; ++q) {
                    const int t = 16 * (tp + q) + i, s0 = 16 * si + 4 * g;
                    u32x2 o; o.x = cvt_pk_bf16(s0 <= t ? sa[q][0] : 0.f, s0 + 1 <= t ? sa[q][1] : 0.f); o.y = cvt_pk_bf16(s0 + 2 <= t ? sa[q][2] : 0.f, s0 + 3 <= t ? sa[q][3] : 0.f);
                    *(LAS u32x2*)(lds + HG_SC + t * HG_RS64 + s0 * 2) = o;
                }
            }
            __syncthreads();
            {
                f32x4 oa[4];
#pragma unroll
                for (int q = 0; q < 4; ++q) oa[q] = (f32x4){0.f, 0.f, 0.f, 0.f};
#pragma unroll
                for (int kk = 0; kk < 2; ++kk) {
                    const bf16x8 A = *(const LAS bf16x8*)(lds + HG_VT + (16 * w + i) * HG_RS64 + (32 * kk + 8 * g) * 2);
#pragma unroll
                    for (int q = 0; q < 4; ++q) { const bf16x8 B = *(const LAS bf16x8*)(lds + HG_SC + (16 * q + i) * HG_RS64 + (32 * kk + 8 * g) * 2); oa[q] = __builtin_amdgcn_mfma_f32_16x16x32_bf16(A, B, oa[q], 0, 0, 0); }
                }
#pragma unroll
                for (int kk = 0; kk < 4; ++kk) {
                    const bf16x8 A = *(const LAS bf16x8*)(lds + HG_ST + (16 * w + i) * HG_RS + (32 * kk + 8 * g) * 2);
#pragma unroll
                    for (int q = 0; q < 4; ++q) { const bf16x8 B = *(const LAS bf16x8*)(lds + HG_QS + (16 * q + i) * HG_RS + (32 * kk + 8 * g) * 2); oa[q] = __builtin_amdgcn_mfma_f32_16x16x32_bf16(A, B, oa[q], 0, 0, 0); }
                }
#pragma unroll
                for (int q = 0; q < 4; ++q) {
                    const int t = HG_TOK(m, 16 * q + i);
                    if (t >= 0) { u32x2 o; o.x = cvt_pk_bf16(oa[q][0], oa[q][1]); o.y = cvt_pk_bf16(oa[q][2], oa[q][3]); *(u32x2*)(po + (size_t)t * DG + 16 * w + 4 * g) = o; }
                }
            }
            {
                const f32x4 dv = *(const LAS f32x4*)(lds + HG_DEC + (16 * w + 4 * g) * 4);
#pragma unroll
                for (int vi = 0; vi < 8; ++vi) S[vi] = S[vi] * dv;
#pragma unroll
                for (int kk = 0; kk < 2; ++kk) {
                    const bf16x8 A = *(const LAS bf16x8*)(lds + HG_KDT + (16 * w + i) * HG_RS64 + (32 * kk + 8 * g) * 2);
#pragma unroll
                    for (int vi = 0; vi < 8; ++vi) { const bf16x8 B = *(const LAS bf16x8*)(lds + HG_VT + (16 * vi + i) * HG_RS64 + (32 * kk + 8 * g) * 2); S[vi] = __builtin_amdgcn_mfma_f32_16x16x32_bf16(A, B, S[vi], 0, 0, 0); }
                }
            }
            __syncthreads();
        }
#undef HG_TOK
#undef HG_LOADRAW
    }
}
__device__ __forceinline__ void ph_mixers(const P& p, LAS unsigned char* lds, LAS int* ticket) {
    if ((blockIdx.x & 1) == 0) for (int u = blockIdx.x >> 1; u < BATCH * 8; u += (gridDim.x + 1) >> 1) hgrn_unit(p, lds, u);
    for (;;) {
        __syncthreads();
        if (threadIdx.x == 0) *ticket = (int)atomicAdd(p.cnt + 64, 1u);
        __syncthreads();
        const int c = *ticket;
        if (c >= DH) break;
        hyena_channel(p, lds, c);
    }
    __syncthreads();
}

__device__ __forceinline__ void ph_filters(const P& p, float* sm) {
    float* z = sm; float* h1 = sm + 8 * 33; float* h2 = h1 + 8 * 64;
    int tid_ = threadIdx.x; asm volatile("" : "+v"(tid_));
    const int tid = tid_;
    for (int un = blockIdx.x; un < (L / 8) * 4; un += gridDim.x) {
        const int grp = un >> 2, nq = un & 3, j0 = grp * 8;
        __syncthreads();
        if (tid < 8 * 33) {
            const int lg = tid / 33, ft = tid % 33, j = j0 + lg; float v;
            if (ft == 0) v = (float)((double)j / (double)(L - 1));
            else { const int ib = (ft - 1) & 15; const double band = 1e-4 + (double)ib * ((double)(15) - 1e-4) / 15.0; double turns = (double)j * band / (double)L; turns -= floor(turns);
                   const float ang = 6.28318530717958647692f * (float)turns;
                   v = ft <= 16 ? cosf(ang) : -sinf(ang); }
            z[tid] = v;
        }
        __syncthreads();
        { const int lg = tid >> 6, hc = tid & 63; float a = p.fb1[hc];
#pragma unroll
          for (int q = 0; q < 33; ++q) a += z[lg * 33 + q] * p.fw1[q * 64 + hc];
          h1[tid] = sinf(p.ffreq[hc] * a); }
        __syncthreads();
        { const int lg = tid >> 6, hc = tid & 63; float a = p.fb2[hc];
#pragma unroll 16
          for (int q = 0; q < 64; ++q) a += h1[lg * 64 + q] * p.fw2[q * 64 + hc];
          h2[tid] = sinf(p.ffreq[hc] * a); }
        __syncthreads();
        {
            const int n = nq * 512 + tid;
            float acc[8];
#pragma unroll
            for (int lg = 0; lg < 8; ++lg) acc[lg] = 0.f;
#pragma unroll 4
            for (int q4 = 0; q4 < 16; ++q4) { const float w0 = p.fw3[(4 * q4) * 2048 + n], w1 = p.fw3[(4 * q4 + 1) * 2048 + n], w2 = p.fw3[(4 * q4 + 2) * 2048 + n], w3 = p.fw3[(4 * q4 + 3) * 2048 + n];
#pragma unroll
                for (int lg = 0; lg < 8; ++lg) { const float4 hv = *(const float4*)(h2 + lg * 64 + 4 * q4); acc[lg] += (hv.x * w0 + hv.y * w1) + (hv.z * w2 + hv.w * w3); } }
            const int dir = n >> 10, order = (n >> 9) & 1, c = n & 511;
            const float lo = -3.0701134573f  , hi = -15.3505672866f  ;
            const float delta = fabsf(lo + (hi - lo) * (float)c * (1.0f / 511.0f));
            bf16* gp = p.G + ((size_t)order * 512 + c) * GL;
            bf16 ov[8];
#pragma unroll
            for (int lg = 0; lg < 8; ++lg) ov[lg] = f2bf(acc[lg] * __expf(-z[lg * 33] * delta));
            if (dir == 0) {
                u32x4 o; o.x = (unsigned)ov[7] | ((unsigned)ov[6] << 16); o.y = (unsigned)ov[5] | ((unsigned)ov[4] << 16); o.z = (unsigned)ov[3] | ((unsigned)ov[2] << 16); o.w = (unsigned)ov[1] | ((unsigned)ov[0] << 16);
                *(u32x4*)(gp + (L - 8 - j0)) = o;
            } else {
#pragma unroll
                for (int lg = 0; lg < 8; ++lg) if (j0 + lg >= 1) gp[L - 1 + j0 + lg] = ov[lg];
            }
        }
    }
    for (int x = blockIdx.x * blockDim.x + tid; x < 1024 * (GL - (2 * L - 1)); x += gridDim.x * blockDim.x) {
        const int row = x / (GL - (2 * L - 1)), m = (2 * L - 1) + x % (GL - (2 * L - 1));
        p.G[(size_t)row * GL + m] = 0;
    }
    __syncthreads();
}

constexpr int BA_RS = 1040;
__device__ __forceinline__ void ph_buildA2(const P& p, LAS unsigned char* lds) {
    int tid_ = threadIdx.x; asm volatile("" : "+v"(tid_));
    const int tid = tid_, w = __builtin_amdgcn_readfirstlane(tid >> 6), lane = tid & 63;
    float hyn[8], hgn[8];
#pragma unroll
    for (int e = 0; e < 8; ++e) { hyn[e] = p.hy_norm[8 * lane + e]; hgn[e] = p.hg_norm[8 * lane + e]; }
    for (int u = blockIdx.x; u < BATCH * (SEQ / 64); u += gridDim.x) {
        const int b = u / (SEQ / 64), tt = u % (SEQ / 64), t0 = NMETA + 64 * tt;
        __syncthreads();
        {
            const bf16* src = p.z2 + ((size_t)tid * BATCH + b) * LP + t0;
            u32x4 v[8];
#pragma unroll
            for (int q = 0; q < 8; ++q) v[q] = *(const u32x4*)(src + 8 * q);
#pragma unroll
            for (int q = 0; q < 8; ++q) {
                const unsigned wv[4] = {v[q].x, v[q].y, v[q].z, v[q].w};
#pragma unroll
                for (int e = 0; e < 8; ++e) *(LAS bf16*)(lds + (8 * q + e) * BA_RS + tid * 2) = (bf16)((e & 1) ? (wv[e >> 1] >> 16) : (wv[e >> 1] & 0xffffu));
            }
        }
        __syncthreads();
#pragma unroll 2
        for (int jt = 8 * w; jt < 8 * w + 8; ++jt) {
            const size_t tok = (size_t)b * L + t0 + jt; bf16* dst = p.A + ((size_t)b * SEQ + 64 * tt + jt) * D;
            const u32x4 zv = *(const LAS u32x4*)(lds + jt * BA_RS + lane * 16);
            const u32x4 of = *(const u32x4*)(p.o + tok * DG + 8 * lane), ob = *(const u32x4*)(p.o + ((size_t)NTOK + tok) * DG + 8 * lane), gv = *(const u32x4*)(p.pg + blk16((int)tok, 2048 + 8 * lane, NHG / 16));
            float z[8] = {bflo(zv.x), bfhi(zv.x), bflo(zv.y), bfhi(zv.y), bflo(zv.z), bfhi(zv.z), bflo(zv.w), bfhi(zv.w)};
            float ss = 0.f;
#pragma unroll
            for (int e = 0; e < 8; ++e) ss += z[e] * z[e];
            ss = wave_sum(ss);
            const float r = rsqrtf(ss * (1.0f / DH) + EPS);
            u32x4 o; o.x = cvt_pk_bf16(z[0] * r * hyn[0], z[1] * r * hyn[1]); o.y = cvt_pk_bf16(z[2] * r * hyn[2], z[3] * r * hyn[3]);
            o.z = cvt_pk_bf16(z[4] * r * hyn[4], z[5] * r * hyn[5]); o.w = cvt_pk_bf16(z[6] * r * hyn[6], z[7] * r * hyn[7]);
            *(u32x4*)(dst + 8 * lane) = o;
            float ov[8] = {bflo(of.x) + bflo(ob.x), bfhi(of.x) + bfhi(ob.x), bflo(of.y) + bflo(ob.y), bfhi(of.y) + bfhi(ob.y), bflo(of.z) + bflo(ob.z), bfhi(of.z) + bfhi(ob.z), bflo(of.w) + bflo(ob.w), bfhi(of.w) + bfhi(ob.w)};
            const float gg[8] = {bflo(gv.x), bfhi(gv.x), bflo(gv.y), bfhi(gv.y), bflo(gv.z), bfhi(gv.z), bflo(gv.w), bfhi(gv.w)};
            float hs = 0.f;
#pragma unroll
            for (int e = 0; e < 8; ++e) hs += ov[e] * ov[e];
            hs += __shfl_xor(hs, 1); hs += __shfl_xor(hs, 2); hs += __shfl_xor(hs, 4); hs += __shfl_xor(hs, 8);
            const float hr = rsqrtf(hs * (1.0f / 128.0f) + EPS);
            float y[8];
#pragma unroll
            for (int e = 0; e < 8; ++e) y[e] = ov[e] * hr * hgn[e] * siluf_(gg[e]);
            u32x4 o2; o2.x = cvt_pk_bf16(y[0], y[1]); o2.y = cvt_pk_bf16(y[2], y[3]); o2.z = cvt_pk_bf16(y[4], y[5]); o2.w = cvt_pk_bf16(y[6], y[7]);
            *(u32x4*)(dst + DH + 8 * lane) = o2;
        }
    }
    __syncthreads();
}

__device__ __forceinline__ void ph_conv_router(const P& p) {
    for (int idx = blockIdx.x * blockDim.x + threadIdx.x; idx < 80 * 1024; idx += gridDim.x * blockDim.x) {
        const int n = idx >> 10, k = idx & 1023;
        const float wv = (n < 8 ? p.w_rg[k * 8 + n] : (n < 72 ? p.w_re[k * 64 + (n - 8)] : 0.f)) * p.norm_ffn[k];
        const bf16 hi = f2bf(wv); p.Wr[idx] = hi; p.Wr[80 * 1024 + idx] = f2bf(wv - bf2f(hi));
    }
}
template <bool DRY>
__device__ __forceinline__ void ph_router(const P& p, LAS unsigned char* lds) {
    int tid_ = threadIdx.x; asm volatile("" : "+v"(tid_));
    const int tid = tid_, w = __builtin_amdgcn_readfirstlane(tid >> 6), lane = tid & 63, i = lane & 15, g = lane >> 4;
    LAS float* lg = (LAS float*)lds + w * (16 * 81 + 16);
    LAS int* lcnt = (LAS int*)(lds + 8 * (16 * 81 + 16) * 4);
    constexpr int RT_WB = 8 * (16 * 81 + 16) * 4 + 1024;
    for (int tile = blockIdx.x; tile < NX / 128; tile += gridDim.x) {
        __syncthreads();
        if (tid < 64) lcnt[tid] = 0;
        __syncthreads();
        const int xr0 = tile * 128 + w * 16;
        const bf16* hrow = p.h1 + (size_t)(xr0 + i) * D + 8 * g;
        f32x4 acc[5];
#pragma unroll
        for (int nt = 0; nt < 5; ++nt) acc[nt] = (f32x4){0.f, 0.f, 0.f, 0.f};
        float ss = 0.f;
        for (int kc = 0; kc < 4; ++kc) {
            __syncthreads();
            for (int x = tid; x < 2 * 80 * 32; x += 512) { const int pl = x / 2560, rem = x % 2560, n = rem >> 5, c16 = rem & 31;
                *(LAS u32x4*)(lds + RT_WB + (pl * 80 + n) * 528 + c16 * 16) = *(const u32x4*)(p.Wr + (size_t)pl * 80 * 1024 + (size_t)n * 1024 + kc * 256 + c16 * 8); }
            __syncthreads();
#pragma unroll 4
            for (int k8 = 0; k8 < 8; ++k8) {
                const u32x4 hv = *(const u32x4*)(hrow + kc * 256 + 32 * k8);
                const float h0 = bflo(hv.x), h1_ = bfhi(hv.x), h2 = bflo(hv.y), h3 = bfhi(hv.y), h4 = bflo(hv.z), h5 = bfhi(hv.z), h6 = bflo(hv.w), h7 = bfhi(hv.w);
                ss += (h0 * h0 + h1_ * h1_) + (h2 * h2 + h3 * h3) + (h4 * h4 + h5 * h5) + (h6 * h6 + h7 * h7);
                const bf16x8 Ah = __builtin_bit_cast(bf16x8, hv);
#pragma unroll
                for (int nt = 0; nt < 5; ++nt) {
                    const bf16x8 bh = *(const LAS bf16x8*)(lds + RT_WB + (16 * nt + i) * 528 + (32 * k8 + 8 * g) * 2), bl = *(const LAS bf16x8*)(lds + RT_WB + (80 + 16 * nt + i) * 528 + (32 * k8 + 8 * g) * 2);
                    acc[nt] = __builtin_amdgcn_mfma_f32_16x16x32_bf16(Ah, bh, acc[nt], 0, 0, 0);
                    acc[nt] = __builtin_amdgcn_mfma_f32_16x16x32_bf16(Ah, bl, acc[nt], 0, 0, 0);
                }
            }
        }
        ss += __shfl_xor(ss, 16); ss += __shfl_xor(ss, 32);
        if (g == 0) lg[16 * 81 + i] = rsqrtf(ss * (1.0f / D) + EPS);
#pragma unroll
        for (int nt = 0; nt < 5; ++nt)
#pragma unroll
            for (int r = 0; r < 4; ++r) lg[(4 * g + r) * 81 + 16 * nt + i] = acc[nt][r];
        asm volatile("s_waitcnt lgkmcnt(0)" ::: "memory");
        int x0 = 0, x1 = 0, l0 = 0, l1 = 0; float gate0 = 0.f, gate1 = 0.f, rs = 0.f;
        if (lane < 16) {
            const LAS float* row = lg + lane * 81; rs = lg[16 * 81 + lane];
            float lgv[8];
#pragma unroll
            for (int q = 0; q < 8; ++q) lgv[q] = row[q] * rs;
            int gs = 0; float best = lgv[0];
#pragma unroll
            for (int q = 1; q < 8; ++q) if (lgv[q] > best) { best = lgv[q]; gs = q; }
            float den = 0.f;
#pragma unroll
            for (int q = 0; q < 8; ++q) den += __expf(lgv[q] - best);
            const float pgroup = 1.0f / den;
            float le[8];
#pragma unroll
            for (int q = 0; q < 8; ++q) le[q] = row[8 + gs * 8 + q] * rs;
            int e0 = 0; float b0 = le[0];
#pragma unroll
            for (int q = 1; q < 8; ++q) if (le[q] > b0) { b0 = le[q]; e0 = q; }
            int e1 = -1; float b1 = -3.0e38f;
#pragma unroll
            for (int q = 0; q < 8; ++q) if (q != e0 && le[q] > b1) { b1 = le[q]; e1 = q; }
            const float q1 = __expf(b1 - b0), inv = 1.0f / (1.0f + q1);
            x0 = gs * 8 + e0; x1 = gs * 8 + e1; gate0 = pgroup * inv; gate1 = pgroup * q1 * inv;
            if (!DRY) { l0 = atomicAdd((int*)(lcnt + x0), 1); l1 = atomicAdd((int*)(lcnt + x1), 1); }
        }
        __syncthreads();
        if (!DRY && tid < 64) { const int c = lcnt[tid]; lcnt[64 + tid] = c ? (int)atomicAdd(p.cnt + tid, (unsigned)c) : 0; }
        __syncthreads();
        if (!DRY && lane < 16) {
            const int xr = xr0 + lane, r0 = lcnt[64 + x0] + l0, r1 = lcnt[64 + x1] + l1;
            p.rstd[xr] = rs;
            p.list[(size_t)x0 * NX + r0] = xr; p.list[(size_t)x1 * NX + r1] = xr; p.rsl[(size_t)x0 * NX + r0] = rs; p.rsl[(size_t)x1 * NX + r1] = rs;
            p.asg_e[xr * 2] = x0; p.asg_e[xr * 2 + 1] = x1; p.asg_rank[xr * 2] = r0; p.asg_rank[xr * 2 + 1] = r1;
            p.asg_gate[xr * 2] = gate0; p.asg_gate[xr * 2 + 1] = gate1;
        }
    }
    __syncthreads();
}

__device__ __forceinline__ void moe_tables(const P& p, int* tb) {
    __syncthreads();
    if (threadIdx.x < NE) tb[threadIdx.x] = (int)xb_ld(p.cnt + threadIdx.x);
    __syncthreads();
    if (threadIdx.x == 0) {
        int s = 0, nt = 0;
        for (int e = 0; e < NE; ++e) { const int c = tb[e]; tb[64 + e] = s;
            for (int j = 0; j < (c + 255) / 256; ++j) { tb[192 + nt] = e; tb[512 + nt] = j * 256; ++nt; }
            s += (c + 255) / 256 * 256; }
        tb[128] = s; tb[129] = nt;
    }
    __syncthreads();
}
struct MoeOrder { const int* tb; int G, c;
    __device__ __forceinline__ bool next(int i, Unit& u) const {
        int rt, pn;
        if ((G & 31) == 0) { const int x = c & 7, q = c >> 3; rt = i * (G >> 2) + x * (G >> 5) + (q >> 2); pn = q & 3; }
        else { const int Lx = i * G + c; rt = Lx >> 2; pn = Lx & 3; }
        if (rt >= tb[129]) return false;
        u.pm = rt; u.pn = pn; u.e = tb[192 + rt]; u.r0 = tb[512 + rt]; return true; } };
struct GMoe1 { const char* A; int kstepA, K; const char* Bt; const int* list; const int* tb;
    __device__ __forceinline__ unsigned aoff(const Unit& u, int r, int C) const { const int rr = u.r0 + r; const int xr = rr < tb[u.e] ? list[(size_t)u.e * NX + rr] : 0; return (unsigned)xr * (D * 2) + (unsigned)(C * 2); }
    __device__ __forceinline__ const char* bptr(const Unit& u) const { return Bt + ((size_t)u.e * 1024 + (size_t)u.pn * BM) * D * 2; } };
struct EpiMoe1 { static constexpr int KIND = 3; bf16* hid; const float* rsl; const int* tb;
    __device__ __forceinline__ void operator()(const f32x4 (&acc)[2][2][4][2], const Unit& u, int wr, int wc, int fr, int fq) const {
        const int cnt = tb[u.e], s0 = tb[64 + u.e] + u.r0;
#pragma unroll
        for (int ai = 0; ai < 2; ++ai)
#pragma unroll
            for (int m = 0; m < 4; ++m) { const int r = ai * HALF + wr * 64 + m * 16 + fr, rr = u.r0 + r; const float rs = rr < cnt ? rsl[(size_t)u.e * NX + rr] : 0.f;
#pragma unroll
                for (int n = 0; n < 2; ++n) { const f32x4 gt = acc[ai][0][m][n] * rs, up = acc[ai][1][m][n] * rs; uint2 o;
                    o.x = cvt_pk_bf16(siluf_(gt[0]) * up[0], siluf_(gt[1]) * up[1]); o.y = cvt_pk_bf16(siluf_(gt[2]) * up[2], siluf_(gt[3]) * up[3]); *(uint2*)(hid + blk16(s0 + r, u.pn * HALF + wc * 32 + n * 16 + 4 * fq, DE / 16)) = o; } }
    } };
__device__ __forceinline__ void ph_moe1(const P& p, LAS unsigned char* lds, const int* tb) {
    GMoe1 g{(const char*)p.h1, BK * 2, D, (const char*)p.Wgu, p.list, tb}; MoeOrder S{tb, (int)gridDim.x, (int)blockIdx.x}; EpiMoe1 E{p.hid, p.rsl, tb};
    gemm_phase(lds, g, S, E);
}
struct GMoe2 { const char* A; int kstepA, K; const char* Bt; const int* tb;
    __device__ __forceinline__ unsigned aoff(const Unit& u, int r, int C) const { return (unsigned)(blk16(tb[64 + u.e] + u.r0 + r, C, DE / 16) * 2); }
    __device__ __forceinline__ const char* bptr(const Unit& u) const { return Bt + ((size_t)u.e * 1024 + (size_t)u.pn * BM) * DE * 2; } };
struct EpiMoe2 { static constexpr int KIND = 4; bf16* y; const int* tb;
    __device__ __forceinline__ void operator()(const f32x4 (&acc)[2][2][4][2], const Unit& u, int wr, int wc, int fr, int fq) const {
        const int s0 = tb[64 + u.e] + u.r0;
#pragma unroll
        for (int ai = 0; ai < 2; ++ai)
#pragma unroll
            for (int m = 0; m < 4; ++m) { const int row = s0 + ai * HALF + wr * 64 + m * 16 + fr, col0 = u.pn * BM + wc * 32 + 4 * fq;
#pragma unroll
                for (int bj = 0; bj < 2; ++bj)
#pragma unroll
                    for (int n = 0; n < 2; ++n) { const f32x4 v = acc[ai][bj][m][n]; uint2 o; o.x = cvt_pk_bf16(v[0], v[1]); o.y = cvt_pk_bf16(v[2], v[3]); *(uint2*)(y + (size_t)row * D + col0 + bj * HALF + n * 16) = o; } }
    } };
__device__ __forceinline__ void ph_moe2(const P& p, LAS unsigned char* lds, const int* tb) {
    GMoe2 g{(const char*)p.hid, 4 * 512, DE, (const char*)p.Wd, tb}; MoeOrder S{tb, (int)gridDim.x, (int)blockIdx.x}; EpiMoe2 E{p.y, tb};
    gemm_phase(lds, g, S, E);
}
__device__ __forceinline__ void ph_final(const P& p, const int* tb) {
    const int* soff = tb + 64;
    int tid_ = threadIdx.x; asm volatile("" : "+v"(tid_));
    const int lane = tid_ & 63, wpb = blockDim.x >> 6;
    const int wave = blockIdx.x * wpb + (tid_ >> 6), nw = gridDim.x * wpb;
    float gn[16];
#pragma unroll
    for (int q = 0; q < 4; ++q) { const float4 g4 = ((const float4*)p.norm_final)[lane * 4 + q]; gn[4 * q] = g4.x; gn[4 * q + 1] = g4.y; gn[4 * q + 2] = g4.z; gn[4 * q + 3] = g4.w; }
    const bool bad = xb_ld(p.bar + XB_TMO) != 0u;
    for (int xr0 = wave; xr0 < NX; xr0 += 2 * nw) {
        const int xrs[2] = {xr0, xr0 + nw < NX ? xr0 + nw : xr0};
        u32x4 hv[2][2], av[2][2], cv[2][2]; float g0[2], g1[2];
#pragma unroll
        for (int q = 0; q < 2; ++q) {
            const int xr = xrs[q];
            const int s0 = soff[p.asg_e[xr * 2]] + p.asg_rank[xr * 2], s1 = soff[p.asg_e[xr * 2 + 1]] + p.asg_rank[xr * 2 + 1];
            g0[q] = p.asg_gate[xr * 2]; g1[q] = p.asg_gate[xr * 2 + 1];
            const bf16* hp = p.h1 + (size_t)xr * D + 16 * lane; const bf16* y0 = p.y + (size_t)s0 * D + 16 * lane; const bf16* y1 = p.y + (size_t)s1 * D + 16 * lane;
            hv[q][0] = *(const u32x4*)hp; hv[q][1] = *(const u32x4*)(hp + 8); av[q][0] = *(const u32x4*)y0; av[q][1] = *(const u32x4*)(y0 + 8); cv[q][0] = *(const u32x4*)y1; cv[q][1] = *(const u32x4*)(y1 + 8);
        }
#pragma unroll
        for (int q = 0; q < 2; ++q) {
            float v[16]; float ss = 0.f;
#pragma unroll
            for (int hq = 0; hq < 2; ++hq) {
                const unsigned hw[4] = {hv[q][hq].x, hv[q][hq].y, hv[q][hq].z, hv[q][hq].w}, aw[4] = {av[q][hq].x, av[q][hq].y, av[q][hq].z, av[q][hq].w}, cw[4] = {cv[q][hq].x, cv[q][hq].y, cv[q][hq].z, cv[q][hq].w};
#pragma unroll
                for (int e = 0; e < 4; ++e) { v[8 * hq + 2 * e] = bflo(hw[e]) + g0[q] * bflo(aw[e]) + g1[q] * bflo(cw[e]); v[8 * hq + 2 * e + 1] = bfhi(hw[e]) + g0[q] * bfhi(aw[e]) + g1[q] * bfhi(cw[e]); }
            }
#pragma unroll
            for (int e = 0; e < 16; ++e) ss += v[e] * v[e];
            ss = wave_sum(ss);
            float r = rsqrtf(ss * (1.0f / D) + EPS);
            if (bad) r = __builtin_nanf("");
            float* op = p.out + (size_t)xrs[q] * D + 16 * lane;
#pragma unroll
            for (int e4 = 0; e4 < 4; ++e4) *(float4*)(op + 4 * e4) = make_float4(v[4 * e4] * r * gn[4 * e4], v[4 * e4 + 1] * r * gn[4 * e4 + 1], v[4 * e4 + 2] * r * gn[4 * e4 + 2], v[4 * e4 + 3] * r * gn[4 * e4 + 3]);
        }
    }
}

constexpr int LDS_SCR = HY_END > STAGE_BYTES ? HY_END : STAGE_BYTES;
constexpr int LDS_BAR = LDS_SCR, LDS_TB = LDS_SCR + 64, LDS_BYTES = LDS_SCR + 64 + 4096;
static_assert(LDS_BYTES <= 160 * 1024 && HG_END <= LDS_SCR, "LDS");

__global__ void __launch_bounds__(512, 2) k_mega(P p) {
    extern __shared__ __attribute__((aligned(16))) unsigned char smraw[];
    float* sm = (float*)smraw;
    LAS unsigned char* lds = (LAS unsigned char*)smraw;
    int* tb = (int*)(smraw + LDS_TB);
    if (threadIdx.x == 0) *(uint4*)(smraw + LDS_BAR) = make_uint4(0u, 0u, 0u, 0u);
    __syncthreads();
    XcdBarrier bar = xcd_barrier_post(p.bar, (volatile LAS unsigned*)(smraw + LDS_BAR));
    ph_norm1(p);
    ph_conv<1>(p, sm, 0, 3);
    ph_conv_router(p);
    ph_filters(p, sm);
    xcd_barrier(bar);
    const int sg = (blockIdx.x >> 3) & 3;
    ph_conv<2>(p, sm, 0, 4 * sg);
    ph_inproj(p, lds);
    ph_conv<2>(p, sm, 4 * sg, 1 << 20);
    xcd_barrier(bar);
    ph_mixers(p, lds, (LAS int*)(smraw + LDS_TB));
    xcd_barrier(bar);
    ph_buildA2(p, lds);
    xcd_barrier(bar);
    ph_conv<0>(p, sm, 0, 8 * sg);
    ph_outproj(p, lds);
    ph_conv<0>(p, sm, 8 * sg, 1 << 20);
    xcd_barrier(bar);
    ph_router<false>(p, lds);
    xcd_barrier(bar);
    moe_tables(p, tb);
    ph_moe1(p, lds, tb);
    xcd_barrier(bar);
    ph_moe2(p, lds, tb);
    xcd_barrier(bar);
    ph_final(p, tb);
}

struct Alloc { size_t off = 0; size_t take(size_t bytes) { const size_t o = off; off += (bytes + 255) & ~(size_t)255; return o; } };
}

extern "C" void kernel_launch(void* const* d_in, const int* in_sizes, int n_in, void* d_out, int out_size, void* d_ws, size_t ws_size, hipStream_t stream) {
    (void)in_sizes; (void)n_in; (void)out_size;
    char* ws = (char*)d_ws;
    P p{};
    const float** ins[] = {&p.x, &p.meta, &p.w_in, &p.conv_w, &p.conv_b, &p.fw1, &p.fb1, &p.fw2, &p.fb2, &p.fw3, &p.ffreq, &p.fskip, &p.hy_norm, &p.lb_f, &p.lb_b,
                           &p.hg_norm, &p.w_out, &p.norm_mix, &p.norm_ffn, &p.w_rg, &p.w_re, &p.w_gate, &p.w_up, &p.w_down, &p.norm_final};
    for (int i = 0; i < 25; ++i) *ins[i] = (const float*)d_in[i];
    p.out = (float*)d_out;
    Alloc a;
    const size_t o_zero = a.take(65536);
    const size_t o_A = a.take((size_t)NX * D * 2);
    const size_t o_Preg = a.off;
    const size_t o_pT = a.take((size_t)NHY * BATCH * LP * 2);
    const size_t o_pg = a.take((size_t)NTOK * NHG * 2);
    const size_t o_G = a.take((size_t)1024 * GL * 2);
    const size_t o_W1t = a.take((size_t)NPROJ * D * 2);
    const size_t o_Hreg = a.off;
    const size_t o_z2 = a.take((size_t)DH * BATCH * LP * 2);
    const size_t o_o = a.take((size_t)2 * NTOK * DG * 2);
    if (a.off < o_Hreg + (size_t)NX * D * 2) a.off = o_Hreg + (size_t)NX * D * 2;
    const size_t o_W2t = a.take((size_t)D * D * 2);
    const size_t o_Wd = a.take((size_t)NE * 1024 * DE * 2);
    const size_t o_Wr = a.take((size_t)2 * 80 * 1024 * 2);
    const size_t o_Am = a.take((size_t)NMETA * D * 2);
    const size_t o_list = a.take((size_t)NE * NX * 4);
    const size_t o_rstd = a.take((size_t)NX * 4);
    const size_t o_rsl = a.take((size_t)NE * NX * 4);
    const size_t o_ae = a.take((size_t)NX * 2 * 4), o_ar = a.take((size_t)NX * 2 * 4), o_ag = a.take((size_t)NX * 2 * 4);
    const size_t sz_wgu = (size_t)NE * 1024 * 1024 * 2, sz_hid = (size_t)MAXSLOT * DE * 2, sz_wd = (size_t)NE * 1024 * DE * 2, sz_y = (size_t)MAXSLOT * D * 2;
    const size_t o_Wgu = o_Preg, o_hid = o_Wgu + sz_wgu, o_y = o_A, o_h1 = o_Hreg;
    (void)sz_wd;
    if (a.off > ws_size || o_hid + sz_hid > o_G || o_y + sz_y > o_Wgu + sz_wgu || o_h1 + (size_t)NX * D * 2 > o_W2t) {
        fprintf(stderr, "workspace map does not fit: need %zu have %zu\n", a.off, ws_size); return; }
    p.bar = (unsigned*)(ws + o_zero); p.cnt = p.bar + 8192;
    p.A = (bf16*)(ws + o_A); p.pT = (bf16*)(ws + o_pT); p.pg = (bf16*)(ws + o_pg); p.G = (bf16*)(ws + o_G); p.z2 = (bf16*)(ws + o_z2); p.o = (bf16*)(ws + o_o);
    p.h1 = (bf16*)(ws + o_h1); p.rstd = (float*)(ws + o_rstd); p.list = (int*)(ws + o_list); p.rsl = (float*)(ws + o_rsl); p.asg_e = (int*)(ws + o_ae); p.asg_rank = (int*)(ws + o_ar); p.asg_gate = (float*)(ws + o_ag);
    p.hid = (bf16*)(ws + o_hid); p.y = (bf16*)(ws + o_y);
    p.W1t = (bf16*)(ws + o_W1t); p.W2t = (bf16*)(ws + o_W2t); p.Wgu = (bf16*)(ws + o_Wgu); p.Wd = (bf16*)(ws + o_Wd); p.Wr = (bf16*)(ws + o_Wr); p.Am = (bf16*)(ws + o_Am);
    hipMemsetAsync(ws + o_zero, 0, 65536, stream);
    static int grid = 0;
    if (!grid) {
        int dev = 0, cus = 0, per_cu = 0;
        hipGetDevice(&dev);
        hipDeviceGetAttribute(&cus, hipDeviceAttributeMultiprocessorCount, dev);
        if (hipFuncSetAttribute((const void*)k_mega, hipFuncAttributeMaxDynamicSharedMemorySize, LDS_BYTES) != hipSuccess) { fprintf(stderr, "hipFuncSetAttribute failed\n"); return; }
        hipOccupancyMaxActiveBlocksPerMultiprocessor(&per_cu, (const void*)k_mega, 512, LDS_BYTES);
        if (per_cu < 1) { fprintf(stderr, "occupancy query says 0 blocks per CU\n"); return; }
        grid = cus;
    }
    k_mega<<<grid, 512, LDS_BYTES, stream>>>(p);
}
```

```cpp
#include <hip/hip_runtime.h>
#include <stdint.h>
#include <stdio.h>

namespace {
typedef unsigned short bf16;
constexpr int D = 1024, BATCH = 16, SEQ = 2048, NMETA = 16, L = SEQ + NMETA;
constexpr int NTOK = BATCH * L;
constexpr int NX = BATCH * SEQ;
constexpr int DH = 512, DG = 512, NHY = 1536, NHG = 2560, NPROJ = 4096;
constexpr int LP = 2080;
constexpr int GL = 4160;
constexpr int NE = 64, DE = 512;
constexpr int MAXSLOT = NX * 2 + NE * 256;
constexpr float EPS = 1e-6f;

__device__ __forceinline__ bf16 f2bf(float f) { unsigned u = __float_as_uint(f); u += 0x7FFFu + ((u >> 16) & 1u); return (bf16)(u >> 16); }
__device__ __forceinline__ float bf2f(bf16 b) { return __uint_as_float(((unsigned)b) << 16); }
__device__ __forceinline__ float wave_sum(float v) {
#pragma unroll
    for (int o = 32; o >= 1; o >>= 1) v += __shfl_xor(v, o);
    return v;
}
__device__ __forceinline__ float sigmoidf_(float x) { return 1.0f / (1.0f + __expf(-x)); }
__device__ __forceinline__ float siluf_(float x) { return x * __builtin_amdgcn_rcpf(1.0f + __builtin_amdgcn_exp2f(-1.44269504f * x)); }

#define XB_TMO      128
#define XB_XCNT(j)  (256  + 64 * (j))
#define XB_XSUB(j)  (1280 + 64 * (j))
#define XB_XGEN(j)  (2304 + 64 * (j))
#define XB_TOP      3328
#define XB_TOPGEN   3392
#define XCD_BAR_WORDS 3456
#define XB_SPIN_CAP (1u << 21)
#define LAS __attribute__((address_space(3)))

__device__ __forceinline__ unsigned xb_ld(unsigned* p)              { return __hip_atomic_load(p, __ATOMIC_RELAXED, __HIP_MEMORY_SCOPE_AGENT); }
__device__ __forceinline__ unsigned xb_add(unsigned* p, unsigned v) { return __hip_atomic_fetch_add(p, v, __ATOMIC_RELAXED, __HIP_MEMORY_SCOPE_AGENT); }
__device__ __forceinline__ unsigned xb_xcc_id() { return (unsigned)__builtin_amdgcn_s_getreg((3 << 11) | 20) & 0xFu; }
#define XB_SPIN(cond, bar) do { unsigned _sp = 0; while (cond) { __builtin_amdgcn_s_sleep(1); \
    if ((++_sp & 255u) == 0u) { if (xb_ld(&(bar)[XB_TMO])) break; if (_sp > XB_SPIN_CAP) { atomicAdd(&(bar)[XB_TMO], 1u); break; } } } } while (0)

struct XcdBarrier {
    unsigned* bar; unsigned x;
    volatile LAS unsigned* st;
};

__device__ __forceinline__ XcdBarrier xcd_barrier_post(unsigned* bar, volatile LAS unsigned* st) {
    XcdBarrier b; b.bar = bar; b.x = xb_xcc_id(); b.st = st;
    if (threadIdx.x == 0) (void)xb_add(&bar[XB_XCNT(b.x)], 1u);
    return b;
}
__device__ __forceinline__ void xcd_barrier_complete(unsigned* bar, unsigned x, unsigned& nloc, unsigned& nx) {
    const unsigned G = gridDim.x * gridDim.y * gridDim.z;
    unsigned sum, cnt, mine, sp = 0u;
    for (;;) {
        sum = 0u; cnt = 0u; mine = 0u;
#pragma unroll
        for (unsigned j = 0; j < 16; ++j) { const unsigned c = xb_ld(&bar[XB_XCNT(j)]); sum += c; cnt += (c > 0u) ? 1u : 0u; mine = (j == x) ? c : mine; }
        if (sum == G) break;
        __builtin_amdgcn_s_sleep(1);
        if ((++sp & 255u) == 0u) { if (xb_ld(&bar[XB_TMO])) break; if (sp > XB_SPIN_CAP) { atomicAdd(&bar[XB_TMO], 1u); break; } }
    }
    nloc = mine > 0u ? mine : 1u; nx = cnt > 0u ? cnt : 1u;
}

__device__ __forceinline__ void xcd_barrier(const XcdBarrier& b) {
    asm volatile("s_waitcnt vmcnt(0)" ::: "memory");
    __syncthreads();
    if (threadIdx.x == 0) {
        unsigned* bar = b.bar;
        __builtin_amdgcn_s_waitcnt(0);
        unsigned nloc = b.st[0], nx = b.st[1];
        if (nloc == 0u) { xcd_barrier_complete(bar, b.x, nloc, nx); b.st[0] = nloc; b.st[1] = nx; }
        const unsigned old = xb_add(&bar[XB_XSUB(b.x)], 1u);
        const unsigned gen = old / nloc;
        if (old + 1u == (gen + 1u) * nloc) {
            __builtin_amdgcn_fence(__ATOMIC_RELEASE, "agent");
            asm volatile("s_waitcnt vmcnt(0)" ::: "memory");
            const unsigned og = xb_add(&bar[XB_TOP], 1u);
            const unsigned tg = og / nx;
            if (og + 1u == (tg + 1u) * nx) xb_add(&bar[XB_TOPGEN], 1u);
            else XB_SPIN(xb_ld(&bar[XB_TOPGEN]) == tg, bar);
            __builtin_amdgcn_fence(__ATOMIC_ACQUIRE, "agent");
            xb_add(&bar[XB_XGEN(b.x)], 1u);
            asm volatile("s_waitcnt vmcnt(0)" ::: "memory");
        } else {
            XB_SPIN(xb_ld(&bar[XB_XGEN(b.x)]) == gen, bar);
            __builtin_amdgcn_fence(__ATOMIC_ACQUIRE, "agent");
            asm volatile("s_waitcnt vmcnt(0)" ::: "memory");
        }
    }
    __syncthreads();
}


struct P {
    const float *x, *meta, *w_in, *conv_w, *conv_b, *fw1, *fb1, *fw2, *fb2, *fw3, *ffreq, *fskip, *hy_norm, *lb_f, *lb_b, *hg_norm,
        *w_out, *norm_mix, *norm_ffn, *w_rg, *w_re, *w_gate, *w_up, *w_down, *norm_final;
    float* out;
    unsigned* bar;
    unsigned* cnt;
    bf16* A;
    bf16* Am;
    bf16* pT;
    bf16* pg;
    bf16* G;
    bf16* z2;
    bf16* o;
    bf16* h1;
    float* rstd;
    int* list;
    float* rsl;
    int* asg_e;
    int* asg_rank;
    float* asg_gate;
    bf16* hid;
    bf16* y;
    bf16 *W1t, *W2t, *Wgu, *Wd;
    bf16* Wr;
};

__device__ __forceinline__ void ph_norm1(const P& p) {
    int tid_ = threadIdx.x; asm volatile("" : "+v"(tid_));
    const int lane = tid_ & 63, wpb = blockDim.x >> 6;
    const int wave = blockIdx.x * wpb + (tid_ >> 6), nw = gridDim.x * wpb;
    float4 gn[4];
#pragma unroll
    for (int i = 0; i < 4; ++i) gn[i] = ((const float4*)p.norm_mix)[i * 64 + lane];
    constexpr int NR = NX + NMETA;
    for (int tok = wave; tok < NR; tok += 2 * nw) {
        const int tk[2] = {tok, tok + nw < NR ? tok + nw : tok};
        float4 v[2][4]; float ss[2];
#pragma unroll
        for (int q = 0; q < 2; ++q) {
            const float* src = tk[q] >= NX ? p.meta + (size_t)(tk[q] - NX) * D : p.x + (size_t)tk[q] * D;
#pragma unroll
            for (int i = 0; i < 4; ++i) v[q][i] = ((const float4*)src)[i * 64 + lane];
        }
#pragma unroll
        for (int q = 0; q < 2; ++q) { float s = 0.f;
#pragma unroll
            for (int i = 0; i < 4; ++i) s += v[q][i].x * v[q][i].x + v[q][i].y * v[q][i].y + v[q][i].z * v[q][i].z + v[q][i].w * v[q][i].w;
            ss[q] = wave_sum(s); }
#pragma unroll
        for (int q = 0; q < 2; ++q) {
            const float r = rsqrtf(ss[q] * (1.0f / D) + EPS);
            bf16* dst = tk[q] >= NX ? p.Am + (size_t)(tk[q] - NX) * D : p.A + (size_t)tk[q] * D;
#pragma unroll
            for (int i = 0; i < 4; ++i) {
                ushort4 o; o.x = f2bf(v[q][i].x * r * gn[i].x); o.y = f2bf(v[q][i].y * r * gn[i].y); o.z = f2bf(v[q][i].z * r * gn[i].z); o.w = f2bf(v[q][i].w * r * gn[i].w);
                ((ushort4*)dst)[i * 64 + lane] = o;
            }
        }
    }
}

typedef short bf16x8 __attribute__((ext_vector_type(8)));
typedef float f32x4 __attribute__((ext_vector_type(4)));
typedef unsigned u32x4 __attribute__((ext_vector_type(4)));
typedef unsigned u32x2 __attribute__((ext_vector_type(2)));
constexpr int BM = 256, BK = 64, HALF = 128, HTB = HALF * BK * 2, STAGE_BYTES = 8 * HTB;
__device__ __forceinline__ int lds_byte(int r, int c) { const int st = (r >> 4) * 2 + (c >> 5), rr = r & 15, cc = c & 31, ob = rr * 64 + cc * 2; return st * 1024 + (ob ^ (((ob >> 9) & 1) << 5)); }
__device__ __forceinline__ void stage_rc(int b, int& R, int& C) { const int st = b / 1024, sb = b % 1024, swz = sb ^ (((sb >> 9) & 1) << 5); R = (st >> 1) * 16 + swz / 64; C = (st & 1) * 32 + (swz % 64) / 2; }
__device__ __forceinline__ unsigned cvt_pk_bf16(float lo, float hi) { unsigned r; asm volatile("v_cvt_pk_bf16_f32 %0, %1, %2" : "=v"(r) : "v"(lo), "v"(hi)); return r; }

__device__ __forceinline__ float4 ld_bf4(const bf16* p) { const ushort4 u = *(const ushort4*)p; return make_float4(bf2f(u.x), bf2f(u.y), bf2f(u.z), bf2f(u.w)); }
__device__ __forceinline__ size_t blk16(int r, int c, int ncb) { return ((size_t)(r >> 4) * ncb + (c >> 4)) * 256 + (r & 15) * 16 + (c & 15); }
struct Unit { int pm, pn, e, r0; };
struct StaticOrder {
    int nM, nN, nwg, G, c;
    __device__ void init(int nM_, int nN_, int G_, int c_) { nM = nM_; nN = nN_; nwg = nM * nN; G = G_; c = c_; }
    __device__ bool next(int i, Unit& u) const {
        const long Lx = (long)i * G + c; if (Lx >= nwg) return false;
        int wgid = (int)Lx; { const int q = nwg / 8, r = nwg % 8, xcd = wgid % 8, off = wgid / 8; wgid = (xcd < r ? xcd * (q + 1) : r * (q + 1) + (xcd - r) * q) + off; }
        const int nig = 8 * nN, gid = wgid / nig, fm = gid * 8, gsz = (nM - fm) < 8 ? (nM - fm) : 8;
        u.pm = fm + ((wgid % nig) % gsz); u.pn = (wgid % nig) / gsz; u.e = 0; u.r0 = 0; return true;
    }
};

template <class GC, class Sched, class Epi>
__device__ __forceinline__ void gemm_phase(LAS unsigned char* lds, const GC& g, const Sched& S, const Epi& E) {
    int tid_ = threadIdx.x; asm volatile("" : "+v"(tid_));
    const int tid = tid_, wid = __builtin_amdgcn_readfirstlane(tid >> 6), lane = tid & 63, wr = wid >> 2, wc = wid & 3, fr = lane & 15, fq = lane >> 4;
    const int K = g.K, nt = K / BK;
    int Rr[2], Cc[2]; unsigned voffB[2];
#pragma unroll
    for (int i = 0; i < 2; ++i) { stage_rc(tid * 16 + i * 8192, Rr[i], Cc[i]); voffB[i] = (unsigned)(Rr[i] * K + Cc[i]) * 2u; }
    const size_t kstep = (size_t)(BK * 2), kstepA = (size_t)g.kstepA;
    const size_t hstepB = (size_t)HALF * K * 2;
    const unsigned ldsw = (unsigned)wid * 1024u;
    const int aoff = lds_byte(wr * 64 + fr, fq * 8), boff = lds_byte(wc * 32 + fr, fq * 8);
#define PG8_SA(b, h) (((b) * 2 + (h)) * HTB)
#define PG8_SB(b, h) ((4 + (b) * 2 + (h)) * HTB)
#define PG8_STAGE(bufoff, gbase, voff) do { _Pragma("unroll") for (int _i = 0; _i < 2; ++_i) \
        __builtin_amdgcn_global_load_lds((const unsigned*)((const char*)(gbase) + (voff)[_i]), (LAS unsigned*)(lds + (bufoff) + ldsw + _i * 8192), 16, 0, 0); } while (0)
#define PG8_LDA(dst, b, h) do { _Pragma("unroll") for (int m = 0; m < 4; ++m) _Pragma("unroll") for (int k = 0; k < 2; ++k) dst[m][k] = *(const LAS bf16x8*)(lds + PG8_SA(b, h) + aoff + m * 2048 + k * 1024); } while (0)
#define PG8_LDB(dst, b, h) do { _Pragma("unroll") for (int n = 0; n < 2; ++n) _Pragma("unroll") for (int k = 0; k < 2; ++k) dst[n][k] = *(const LAS bf16x8*)(lds + PG8_SB(b, h) + boff + n * 2048 + k * 1024); } while (0)
#define PG8_MMA(ai, bj, At, Bt) do { __builtin_amdgcn_s_setprio(1); _Pragma("unroll") for (int m = 0; m < 4; ++m) _Pragma("unroll") for (int n = 0; n < 2; ++n) _Pragma("unroll") for (int k = 0; k < 2; ++k) \
        acc[ai][bj][m][n] = __builtin_amdgcn_mfma_f32_16x16x32_bf16(Bt[n][k], At[m][k], acc[ai][bj][m][n], 0, 0, 0); __builtin_amdgcn_s_setprio(0); } while (0)
#define PG8_WAIT_V(n) asm volatile("s_waitcnt vmcnt(" #n ")" ::: "memory")
#define PG8_WAIT_L(n) asm volatile("s_waitcnt lgkmcnt(" #n ")" ::: "memory")
#define PG8_BAR __builtin_amdgcn_s_barrier()
#define PG8_SCHED __builtin_amdgcn_sched_barrier(0)
    Unit cur, nxt; int ui = 0;
    if (!S.next(0, cur)) return;
    f32x4 acc[2][2][4][2];
#pragma unroll
    for (int a = 0; a < 2; ++a)
#pragma unroll
        for (int b = 0; b < 2; ++b)
#pragma unroll
            for (int m = 0; m < 4; ++m)
#pragma unroll
                for (int n = 0; n < 2; ++n) acc[a][b][m][n] = (f32x4){0.f, 0.f, 0.f, 0.f};
    bf16x8 At[4][2], B0[2][2], B1[2][2];
    unsigned ca[2][2], na[2][2];
#pragma unroll
    for (int h = 0; h < 2; ++h)
#pragma unroll
        for (int i = 0; i < 2; ++i) ca[h][i] = g.aoff(cur, h * HALF + Rr[i], Cc[i]);
    const char* const A0 = g.A;
    const char* cB = g.bptr(cur);
    PG8_STAGE(PG8_SB(0, 0), cB, voffB); PG8_STAGE(PG8_SA(0, 0), A0, ca[0]); PG8_STAGE(PG8_SB(0, 1), cB + hstepB, voffB); PG8_STAGE(PG8_SA(0, 1), A0, ca[1]);
    if (wr == 1) PG8_BAR;
    PG8_WAIT_V(4); PG8_BAR;
    PG8_STAGE(PG8_SB(1, 0), cB + kstep, voffB); PG8_STAGE(PG8_SA(1, 0), A0 + kstepA, ca[0]); PG8_STAGE(PG8_SB(1, 1), cB + hstepB + kstep, voffB);
    PG8_WAIT_V(6); PG8_BAR;
    for (;;) {
        const bool has_next = S.next(ui + 1, nxt);
        const char* nB = cB;
#pragma unroll
        for (int h = 0; h < 2; ++h)
#pragma unroll
            for (int i = 0; i < 2; ++i) na[h][i] = ca[h][i];
        if (has_next) {
            nB = g.bptr(nxt);
#pragma unroll
            for (int h = 0; h < 2; ++h)
#pragma unroll
                for (int i = 0; i < 2; ++i) na[h][i] = g.aoff(nxt, h * HALF + Rr[i], Cc[i]);
        }
        for (int t = 0; t < nt; t += 2) {
            const bool last = (t == nt - 2);
            const char* a1 = A0 + (size_t)(t + 1) * kstepA;
            const char* a2 = last ? A0 : A0 + (size_t)(t + 2) * kstepA; const char* b2 = last ? nB : cB + (size_t)(t + 2) * kstep;
            const char* a3 = a2 + kstepA; const char* b3 = b2 + kstep;
            unsigned s0[2], s1[2];
            s0[0] = last ? na[0][0] : ca[0][0]; s0[1] = last ? na[0][1] : ca[0][1]; s1[0] = last ? na[1][0] : ca[1][0]; s1[1] = last ? na[1][1] : ca[1][1];
            PG8_LDB(B0, 0, 0); PG8_SCHED; PG8_LDA(At, 0, 0); PG8_STAGE(PG8_SA(1, 1), a1, ca[1]);
            PG8_WAIT_L(8); PG8_BAR; PG8_WAIT_L(0); PG8_MMA(0, 0, At, B0); PG8_BAR; PG8_SCHED;
            PG8_LDB(B1, 0, 1); PG8_STAGE(PG8_SB(0, 0), b2, voffB);
            PG8_BAR; PG8_WAIT_L(0); PG8_MMA(0, 1, At, B1); PG8_BAR;
            PG8_LDA(At, 0, 1); PG8_STAGE(PG8_SA(0, 0), a2, s0);
            PG8_BAR; PG8_WAIT_L(0); PG8_MMA(1, 0, At, B0); PG8_BAR; PG8_SCHED;
            PG8_STAGE(PG8_SB(0, 1), b2 + hstepB, voffB);
            PG8_WAIT_V(6); PG8_BAR; PG8_MMA(1, 1, At, B1); PG8_BAR;
            PG8_LDB(B0, 1, 0); PG8_SCHED; PG8_LDA(At, 1, 0); PG8_STAGE(PG8_SA(0, 1), a2, s1);
            PG8_WAIT_L(8); PG8_BAR; PG8_WAIT_L(0); PG8_MMA(0, 0, At, B0); PG8_BAR; PG8_SCHED;
            PG8_LDB(B1, 1, 1); PG8_STAGE(PG8_SB(1, 0), b3, voffB);
            PG8_BAR; PG8_WAIT_L(0); PG8_MMA(0, 1, At, B1); PG8_BAR;
            PG8_LDA(At, 1, 1); PG8_STAGE(PG8_SA(1, 0), a3, s0);
            PG8_BAR; PG8_WAIT_L(0); PG8_MMA(1, 0, At, B0); PG8_BAR; PG8_SCHED;
            PG8_STAGE(PG8_SB(1, 1), b3 + hstepB, voffB);
            PG8_WAIT_V(6); PG8_BAR; PG8_MMA(1, 1, At, B1); PG8_BAR;
        }
        E(acc, cur, wr, wc, fr, fq);
        if (!has_next) break;
#pragma unroll
        for (int a = 0; a < 2; ++a)
#pragma unroll
            for (int b = 0; b < 2; ++b)
#pragma unroll
                for (int m = 0; m < 4; ++m)
#pragma unroll
                    for (int n = 0; n < 2; ++n) acc[a][b][m][n] = (f32x4){0.f, 0.f, 0.f, 0.f};
        cur = nxt; cB = nB; ++ui;
#pragma unroll
        for (int h = 0; h < 2; ++h)
#pragma unroll
            for (int i = 0; i < 2; ++i) ca[h][i] = na[h][i];
    }
    PG8_WAIT_V(0);
    if (wr == 0) PG8_BAR;
    PG8_BAR;
#undef PG8_SA
#undef PG8_SB
#undef PG8_STAGE
#undef PG8_LDA
#undef PG8_LDB
#undef PG8_MMA
#undef PG8_WAIT_V
#undef PG8_WAIT_L
#undef PG8_BAR
#undef PG8_SCHED
}

template <class RM>
__device__ __forceinline__ void tconv_tile(const float* src, int ldn, int k0, int n0, bf16* dst, int ldd, RM rm, float* tile, const float* kscale = nullptr) {
    const int tid = threadIdx.x;
    __syncthreads();
    for (int idx = tid; idx < 1024; idx += blockDim.x) {
        const int kk = idx >> 4, nq = (idx & 15) * 4; float4 v = *(const float4*)(src + (size_t)(k0 + kk) * ldn + n0 + nq);
        if (kscale) { const float s = kscale[k0 + kk]; v.x *= s; v.y *= s; v.z *= s; v.w *= s; }
        float* tp = tile + kk * 65 + nq; tp[0] = v.x; tp[1] = v.y; tp[2] = v.z; tp[3] = v.w;
    }
    __syncthreads();
    { const int n = tid >> 3, kq = (tid & 7) * 8; const float* tp = tile + kq * 65 + n;
      uint4 o; o.x = cvt_pk_bf16(tp[0], tp[65]); o.y = cvt_pk_bf16(tp[130], tp[195]); o.z = cvt_pk_bf16(tp[260], tp[325]); o.w = cvt_pk_bf16(tp[390], tp[455]);
      *(uint4*)(dst + (size_t)rm(n0 + n) * ldd + k0 + kq) = o; }
}
struct CvDesc { const float* src; bf16* dst; int ldn, ldd, scale, k0; };
template <int MODE>
__device__ __forceinline__ CvDesc cv_decode(const P& p, int u) {
    CvDesc d;
    if (MODE == 1) {
        if (u < 512) { const int kt = u & 15, nt = u >> 4; d.src = p.w_in + (size_t)(kt * 64) * NPROJ + nt * 128; d.ldn = NPROJ; d.dst = p.W1t + (size_t)(nt * 128) * D + kt * 64; }
        else { const int q = u - 512, kt = q & 15, nt = q >> 4; d.src = p.w_out + (size_t)(kt * 64) * D + nt * 128; d.ldn = D; d.dst = p.W2t + (size_t)(nt * 128) * D + kt * 64; }
        d.ldd = D; d.scale = 0; d.k0 = 0; return d;
    }
    if (MODE == 0) { const int e = u >> 7, v = u & 127, w = v >> 6, q = v & 63, kt = q & 15, nt = q >> 4;
        d.src = (w ? p.w_up : p.w_gate) + (size_t)e * D * DE + (size_t)(kt * 64) * DE + nt * 128; d.ldn = DE; d.k0 = kt * 64; d.scale = 1;
        d.dst = p.Wgu + ((size_t)e * 1024 + nt * 256 + w * 128) * D + kt * 64; d.ldd = D; }
    else { const int e = u >> 6, q = u & 63, kt = q & 7, nt = q >> 3;
        d.src = p.w_down + (size_t)e * DE * D + (size_t)(kt * 64) * D + nt * 128; d.ldn = D; d.k0 = kt * 64; d.scale = 0;
        d.dst = p.Wd + ((size_t)e * 1024 + nt * 128) * DE + kt * 64; d.ldd = DE; }
    return d;
}
template <int MODE>
__device__ __forceinline__ void ph_conv(const P& p, float* tile, int it0, int it1) {
    int tid_ = threadIdx.x; asm volatile("" : "+v"(tid_));
    const int tid = tid_, total = MODE == 1 ? 640 : (MODE == 0 ? NE * 128 : NE * 64);
    float4 cur[4], nxt[4];
    int u = blockIdx.x + it0 * gridDim.x;
    const int uend = (long)blockIdx.x + (long)it1 * gridDim.x < total ? blockIdx.x + it1 * gridDim.x : total;
    CvDesc dc{};
    if (u < uend) { dc = cv_decode<MODE>(p, u);
#pragma unroll
        for (int q = 0; q < 4; ++q) { const int idx = tid + 512 * q, kk = idx >> 5, nq = (idx & 31) * 4; cur[q] = *(const float4*)(dc.src + (size_t)kk * dc.ldn + nq); } }
    for (; u < uend; u += gridDim.x) {
        const int un = u + gridDim.x; CvDesc dn = dc;
        if (un < uend) { dn = cv_decode<MODE>(p, un);
#pragma unroll
            for (int q = 0; q < 4; ++q) { const int idx = tid + 512 * q, kk = idx >> 5, nq = (idx & 31) * 4; nxt[q] = *(const float4*)(dn.src + (size_t)kk * dn.ldn + nq); } }
        __syncthreads();
#pragma unroll
        for (int q = 0; q < 4; ++q) { const int idx = tid + 512 * q, kk = idx >> 5, nq = (idx & 31) * 4; const float s = dc.scale ? p.norm_ffn[dc.k0 + kk] : 1.0f;
            float* tp = tile + kk * 129 + nq; tp[0] = cur[q].x * s; tp[1] = cur[q].y * s; tp[2] = cur[q].z * s; tp[3] = cur[q].w * s; }
        __syncthreads();
        { const int n = tid >> 2, kq = (tid & 3) * 16; const float* tp = tile + kq * 129 + n;
          u32x4 o0, o1;
          o0.x = cvt_pk_bf16(tp[0], tp[129]); o0.y = cvt_pk_bf16(tp[2 * 129], tp[3 * 129]); o0.z = cvt_pk_bf16(tp[4 * 129], tp[5 * 129]); o0.w = cvt_pk_bf16(tp[6 * 129], tp[7 * 129]);
          o1.x = cvt_pk_bf16(tp[8 * 129], tp[9 * 129]); o1.y = cvt_pk_bf16(tp[10 * 129], tp[11 * 129]); o1.z = cvt_pk_bf16(tp[12 * 129], tp[13 * 129]); o1.w = cvt_pk_bf16(tp[14 * 129], tp[15 * 129]);
          bf16* dp = dc.dst + (size_t)n * dc.ldd + kq; *(u32x4*)dp = o0; *(u32x4*)(dp + 8) = o1; }
        dc = dn;
#pragma unroll
        for (int q = 0; q < 4; ++q) cur[q] = nxt[q];
    }
    __syncthreads();
}

template <int MODE>
__device__ __forceinline__ void ph_conv_pair(const P& p, float* tile, int it0, int it1) {
    int tid_ = threadIdx.x; asm volatile("" : "+v"(tid_));
    const int tid = tid_, total = MODE == 1 ? 640 : (MODE == 0 ? NE * 128 : NE * 64);
    for (int it = it0; it < it1; ++it) {
        for (int q2 = 0; q2 < 2; ++q2) {
            const int u = (int)blockIdx.x - 1 + q2 + it * (int)gridDim.x; if (u >= total) break;
            const CvDesc dc = cv_decode<MODE>(p, u);
            float4 cur[4];
#pragma unroll
            for (int q = 0; q < 4; ++q) { const int idx = tid + 512 * q, kk = idx >> 5, nq = (idx & 31) * 4; cur[q] = *(const float4*)(dc.src + (size_t)kk * dc.ldn + nq); }
            __syncthreads();
#pragma unroll
            for (int q = 0; q < 4; ++q) { const int idx = tid + 512 * q, kk = idx >> 5, nq = (idx & 31) * 4; const float s = dc.scale ? p.norm_ffn[dc.k0 + kk] : 1.0f;
                float* tp = tile + kk * 129 + nq; tp[0] = cur[q].x * s; tp[1] = cur[q].y * s; tp[2] = cur[q].z * s; tp[3] = cur[q].w * s; }
            __syncthreads();
            { const int n = tid >> 2, kq = (tid & 3) * 16; const float* tp = tile + kq * 129 + n;
              u32x4 o0, o1;
              o0.x = cvt_pk_bf16(tp[0], tp[129]); o0.y = cvt_pk_bf16(tp[2 * 129], tp[3 * 129]); o0.z = cvt_pk_bf16(tp[4 * 129], tp[5 * 129]); o0.w = cvt_pk_bf16(tp[6 * 129], tp[7 * 129]);
              o1.x = cvt_pk_bf16(tp[8 * 129], tp[9 * 129]); o1.y = cvt_pk_bf16(tp[10 * 129], tp[11 * 129]); o1.z = cvt_pk_bf16(tp[12 * 129], tp[13 * 129]); o1.w = cvt_pk_bf16(tp[14 * 129], tp[15 * 129]);
              bf16* dp = dc.dst + (size_t)n * dc.ldd + kq; *(u32x4*)dp = o0; *(u32x4*)(dp + 8) = o1; }
        }
    }
    __syncthreads();
}

struct GIn { const char* A; int kstepA, K; const char* Bt;
    __device__ __forceinline__ unsigned aoff(const Unit& u, int r, int C) const { const int row = u.pm * BM + (u.pn < NHY / BM ? (r & ~63) + 4 * (r & 15) + ((r >> 4) & 3) : r); return (unsigned)row * (D * 2) + (unsigned)(C * 2); }
    __device__ __forceinline__ const char* bptr(const Unit& u) const { return Bt + (size_t)u.pn * BM * K * 2; } };
struct EpiIn { static constexpr int KIND = 1; bf16* pT; bf16* pg;
    __device__ __forceinline__ void operator()(const f32x4 (&acc)[2][2][4][2], const Unit& u, int wr, int wc, int fr, int fq) const {
        if (u.pn < NHY / BM) {
#pragma unroll
            for (int ai = 0; ai < 2; ++ai) { const int xr = u.pm * BM + ai * HALF + wr * 64 + 4 * fr, b = xr / SEQ, t = NMETA + xr % SEQ;
#pragma unroll
                for (int bj = 0; bj < 2; ++bj)
#pragma unroll
                    for (int n = 0; n < 2; ++n)
#pragma unroll
                        for (int j = 0; j < 4; ++j) { const int col = u.pn * BM + bj * HALF + wc * 32 + n * 16 + 4 * fq + j;
                            uint2 o; o.x = cvt_pk_bf16(acc[ai][bj][0][n][j], acc[ai][bj][1][n][j]); o.y = cvt_pk_bf16(acc[ai][bj][2][n][j], acc[ai][bj][3][n][j]);
                            *(uint2*)(pT + ((size_t)col * BATCH + b) * LP + t) = o; } }
        } else {
            const int act = 0;
#pragma unroll
            for (int ai = 0; ai < 2; ++ai)
#pragma unroll
                for (int m = 0; m < 4; ++m) { const int xr = u.pm * BM + ai * HALF + wr * 64 + m * 16 + fr; const int tok = (xr / SEQ) * L + NMETA + xr % SEQ;
#pragma unroll
                    for (int bj = 0; bj < 2; ++bj)
#pragma unroll
                        for (int n = 0; n < 2; ++n) { f32x4 v = acc[ai][bj][m][n];
                            if (act) {
#pragma unroll
                                for (int j = 0; j < 4; ++j) { const float sgm = __builtin_amdgcn_rcpf(1.0f + __builtin_amdgcn_exp2f(-1.44269504f * v[j])); v[j] = act == 1 ? v[j] * sgm : sgm; } }
                            uint2 o; o.x = cvt_pk_bf16(v[0], v[1]); o.y = cvt_pk_bf16(v[2], v[3]);
                            *(uint2*)(pg + blk16(tok, (u.pn * BM - NHY) + bj * HALF + wc * 32 + n * 16 + 4 * fq, NHG / 16)) = o; } }
        }
    } };
__device__ __forceinline__ void ph_inproj_meta(const P& p, LAS unsigned char* lds) {
    int tid_ = threadIdx.x; asm volatile("" : "+v"(tid_));
    const int tid = tid_, w = __builtin_amdgcn_readfirstlane(tid >> 6), lane = tid & 63, i = lane & 15, g = lane >> 4;
    LAS float* part = (LAS float*)lds;
    for (int ct = blockIdx.x; ct < NPROJ / 16; ct += gridDim.x) {
        __syncthreads();
        f32x4 acc = (f32x4){0.f, 0.f, 0.f, 0.f};
#pragma unroll
        for (int kk = 0; kk < 4; ++kk) {
            const int k = 128 * w + 32 * kk + 8 * g;
            const bf16x8 a = *(const bf16x8*)(p.W1t + (size_t)(16 * ct + i) * D + k), bb = *(const bf16x8*)(p.Am + (size_t)i * D + k);
            acc = __builtin_amdgcn_mfma_f32_16x16x32_bf16(a, bb, acc, 0, 0, 0);
        }
#pragma unroll
        for (int r = 0; r < 4; ++r) part[(w * 16 + 4 * g + r) * 17 + i] = acc[r];
        __syncthreads();
        if (tid < 256) {
            const int cl = tid >> 4, t = tid & 15, col = 16 * ct + cl; float v = 0.f;
#pragma unroll
            for (int ww = 0; ww < 8; ++ww) v += part[(ww * 16 + cl) * 17 + t];
            if (col < NHY) { const bf16 o = f2bf(v);
#pragma unroll
                for (int b = 0; b < BATCH; ++b) p.pT[((size_t)col * BATCH + b) * LP + t] = o; }
            else { const int act = 0;
                if (act) { const float sgm = __builtin_amdgcn_rcpf(1.0f + __builtin_amdgcn_exp2f(-1.44269504f * v)); v = act == 1 ? v * sgm : sgm; }
                const bf16 o = f2bf(v);
#pragma unroll
                for (int b = 0; b < BATCH; ++b) p.pg[blk16(b * L + t, col - NHY, NHG / 16)] = o; }
        }
    }
    __syncthreads();
}
__device__ __forceinline__ void ph_inproj(const P& p, LAS unsigned char* lds) {
    GIn g{(const char*)p.A, BK * 2, D, (const char*)p.W1t}; StaticOrder S; S.init(NX / BM, NPROJ / BM, gridDim.x, blockIdx.x); EpiIn E{p.pT, p.pg};
    gemm_phase(lds, g, S, E);
    ph_inproj_meta(p, lds);
}
struct GOut { const char* A; int kstepA, K; const char* Bt;
    __device__ __forceinline__ unsigned aoff(const Unit& u, int r, int C) const { return (unsigned)(u.pm * BM + r) * (D * 2) + (unsigned)(C * 2); }
    __device__ __forceinline__ const char* bptr(const Unit& u) const { return Bt + (size_t)u.pn * BM * K * 2; } };
struct EpiOut { static constexpr int KIND = 2; const float* x; bf16* h1;
    __device__ __forceinline__ void operator()(const f32x4 (&acc)[2][2][4][2], const Unit& u, int wr, int wc, int fr, int fq) const {
#pragma unroll
        for (int ai = 0; ai < 2; ++ai)
#pragma unroll
            for (int m = 0; m < 4; ++m) { const int row = u.pm * BM + ai * HALF + wr * 64 + m * 16 + fr, col0 = u.pn * BM + wc * 32 + 4 * fq;
#pragma unroll
                for (int bj = 0; bj < 2; ++bj)
#pragma unroll
                    for (int n = 0; n < 2; ++n) { const int col = col0 + bj * HALF + n * 16; const f32x4 v = *(const f32x4*)(x + (size_t)row * D + col) + acc[ai][bj][m][n];
                        u32x2 o; o.x = cvt_pk_bf16(v[0], v[1]); o.y = cvt_pk_bf16(v[2], v[3]); *(u32x2*)(h1 + (size_t)row * D + col) = o; } }
    } };
__device__ __forceinline__ void ph_outproj(const P& p, LAS unsigned char* lds) {
    GOut g{(const char*)p.A, BK * 2, D, (const char*)p.W2t}; StaticOrder S; S.init(NX / BM, D / BM, gridDim.x, blockIdx.x); EpiOut E{p.x, p.h1};
    gemm_phase(lds, g, S, E);
}

constexpr int ZS = 2088, ZSB = ZS * 2;
constexpr int HY_ZB = 0, HY_Z1 = 16 * ZSB, HY_G0 = 2 * 16 * ZSB, HY_G1 = HY_G0 + GL * 2, HY_END = HY_G1 + GL * 2;
typedef short bf16x8a __attribute__((ext_vector_type(8), aligned(4)));

__device__ __forceinline__ float bflo(unsigned u) { return __uint_as_float(u << 16); }
__device__ __forceinline__ float bfhi(unsigned u) { return __uint_as_float(u & 0xffff0000u); }

__device__ __forceinline__ void hy_load_conv(const P& p, int col, LAS unsigned char* dst) {
    const float w0 = p.conv_w[col], w1 = p.conv_w[NHY + col], w2 = p.conv_w[2 * NHY + col], bb = p.conv_b[col];
    for (int gi = threadIdx.x; gi < 16 * (ZS / 8); gi += blockDim.x) {
        const int b = gi / (ZS / 8), t0 = (gi % (ZS / 8)) * 8;
        u32x4 o = (u32x4){0u, 0u, 0u, 0u};
        if (t0 < L) {
            const bf16* src = p.pT + ((size_t)col * BATCH + b) * LP + t0;
            const u32x4 v = *(const u32x4*)src;
            float f[10];
            f[0] = t0 > 0 ? bf2f(src[-1]) : 0.f; f[9] = (t0 + 8 < L) ? bf2f(src[8]) : 0.f;
            f[1] = bflo(v.x); f[2] = bfhi(v.x); f[3] = bflo(v.y); f[4] = bfhi(v.y); f[5] = bflo(v.z); f[6] = bfhi(v.z); f[7] = bflo(v.w); f[8] = bfhi(v.w);
            float u[8];
#pragma unroll
            for (int j = 0; j < 8; ++j) u[j] = bb + w0 * f[j] + w1 * f[j + 1] + w2 * f[j + 2];
            o.x = cvt_pk_bf16(u[0], u[1]); o.y = cvt_pk_bf16(u[2], u[3]); o.z = cvt_pk_bf16(u[4], u[5]); o.w = cvt_pk_bf16(u[6], u[7]);
        }
        *(LAS u32x4*)(dst + b * ZSB + t0 * 2) = o;
    }
}
__device__ __forceinline__ void hy_load_taps(const P& p, int order, int c, LAS unsigned char* lds) {
    const bf16* src = p.G + ((size_t)order * 512 + c) * GL;
    for (int k = threadIdx.x; k < GL / 8; k += blockDim.x) {
        const u32x4 v = *(const u32x4*)(src + k * 8);
        const unsigned nx = (k * 8 + 8 < GL) ? (unsigned)src[k * 8 + 8] : 0u;
        *(LAS u32x4*)(lds + HY_G0 + k * 16) = v;
        u32x4 s; s.x = (v.x >> 16) | (v.y << 16); s.y = (v.y >> 16) | (v.z << 16); s.z = (v.z >> 16) | (v.w << 16); s.w = (v.w >> 16) | (nx << 16);
        *(LAS u32x4*)(lds + HY_G1 + k * 16) = s;
    }
}
template <int STAGE>
__device__ __forceinline__ void hy_stage(const P& p, LAS unsigned char* lds, int c, float skip) {
    int tid_ = threadIdx.x; asm volatile("" : "+v"(tid_));
    const int tid = tid_, w = __builtin_amdgcn_readfirstlane(tid >> 6), lane = tid & 63, i = lane & 15, g = lane >> 4;
    const int it0 = w * 17;
    const LAS unsigned char* zsrc = lds + (STAGE == 0 ? HY_ZB : HY_Z1) + i * ZSB + g * 16;
    const LAS unsigned char* gl0 = ((i & 1) ? lds + HY_G0 + 2 * (8 * g - i + L - 1) : lds + HY_G1 + 2 * (8 * g - i + L - 2)) - 32 * it0;
    f32x4 acc[17];
#pragma unroll
    for (int a = 0; a < 17; ++a) acc[a] = (f32x4){0.f, 0.f, 0.f, 0.f};
    bf16x8 R[20];
#pragma unroll
    for (int a = 0; a < 17; ++a) R[a] = *(const LAS bf16x8a*)(gl0 - 32 * a);
    bf16x8 Zc = *(const LAS bf16x8*)zsrc, Zn = Zc;
    const bool full = (w != 7);
#define HY_STEP(u, js, PF) do { \
        if (PF) { R[(40 - 2 * ((u) + 1)) % 20] = *(const LAS bf16x8a*)(gl0 + 64 * ((js) + 1)); R[(41 - 2 * ((u) + 1)) % 20] = *(const LAS bf16x8a*)(gl0 + 64 * ((js) + 1) - 32); \
                  Zn = *(const LAS bf16x8*)(zsrc + 64 * ((js) + 1)); } \
        _Pragma("unroll") for (int a = 0; a < 10; ++a) acc[a] = __builtin_amdgcn_mfma_f32_16x16x32_bf16(R[(a + 40 - 2 * (u)) % 20], Zc, acc[a], 0, 0, 0); \
        if (full) { _Pragma("unroll") for (int a = 10; a < 17; ++a) acc[a] = __builtin_amdgcn_mfma_f32_16x16x32_bf16(R[(a + 40 - 2 * (u)) % 20], Zc, acc[a], 0, 0, 0); } \
        Zc = Zn; } while (0)
    for (int jb = 0; jb < 60; jb += 10) {
#pragma unroll
        for (int u = 0; u < 10; ++u) HY_STEP(u, jb + u, true);
    }
#pragma unroll
    for (int u = 0; u < 5; ++u) HY_STEP(u, 60 + u, u < 4);
#undef HY_STEP
#pragma unroll
    for (int a = 0; a < 17; ++a) {
        const int it = it0 + a;
        if (it < 129) {
            const int t = 16 * it + 4 * g, ad = i * ZSB + t * 2;
            const u32x2 zv = *(const LAS u32x2*)(lds + HY_ZB + ad), z1v = *(const LAS u32x2*)(lds + HY_Z1 + ad);
            if (STAGE == 0) {
                u32x2 o;
                o.x = cvt_pk_bf16(bflo(z1v.x) * (acc[a][0] + skip * bflo(zv.x)), bfhi(z1v.x) * (acc[a][1] + skip * bfhi(zv.x)));
                o.y = cvt_pk_bf16(bflo(z1v.y) * (acc[a][2] + skip * bflo(zv.y)), bfhi(z1v.y) * (acc[a][3] + skip * bfhi(zv.y)));
                *(LAS u32x2*)(lds + HY_Z1 + ad) = o;
            } else {
                u32x2 o;
                o.x = cvt_pk_bf16(bflo(zv.x) * (acc[a][0] + skip * bflo(z1v.x)), bfhi(zv.x) * (acc[a][1] + skip * bfhi(z1v.x)));
                o.y = cvt_pk_bf16(bflo(zv.y) * (acc[a][2] + skip * bflo(z1v.y)), bfhi(zv.y) * (acc[a][3] + skip * bfhi(z1v.y)));
                *(u32x2*)(p.z2 + ((size_t)c * BATCH + i) * LP + t) = o;
            }
        }
    }
}
__device__ __forceinline__ void hyena_channel(const P& p, LAS unsigned char* lds, int c) {
    {
        __syncthreads();
        hy_load_conv(p, c, lds + HY_ZB); hy_load_conv(p, DH + c, lds + HY_Z1); hy_load_taps(p, 0, c, lds);
        __syncthreads();
        hy_stage<0>(p, lds, c, p.fskip[c]);
        __syncthreads();
        hy_load_conv(p, 2 * DH + c, lds + HY_ZB); hy_load_taps(p, 1, c, lds);
        __syncthreads();
        hy_stage<1>(p, lds, c, p.fskip[DH + c]);
    }
}

constexpr int HG_RS = 272, HG_RS64 = 144;
constexpr int HG_QS = 0, HG_KS = HG_QS + 64 * HG_RS, HG_KDT = HG_KS + 64 * HG_RS, HG_VT = HG_KDT + 128 * HG_RS64, HG_SC = HG_VT + 128 * HG_RS64, HG_ST = HG_SC + 64 * HG_RS64,
              HG_DEC = HG_ST + 128 * HG_RS, HG_EBM = HG_DEC + 128 * 4, HG_END = HG_EBM + 128 * 4;
__device__ __forceinline__ float dpp_add_(float v, const int ctrl_sel) {
    int t;
    const int iv = __float_as_int(v);
    if (ctrl_sel == 0) t = __builtin_amdgcn_update_dpp(0, iv, 0x111, 0xf, 0xf, false);
    else if (ctrl_sel == 1) t = __builtin_amdgcn_update_dpp(0, iv, 0x112, 0xf, 0xf, false);
    else if (ctrl_sel == 2) t = __builtin_amdgcn_update_dpp(0, iv, 0x114, 0xf, 0xf, false);
    else if (ctrl_sel == 3) t = __builtin_amdgcn_update_dpp(0, iv, 0x118, 0xf, 0xf, false);
    else if (ctrl_sel == 4) t = __builtin_amdgcn_update_dpp(0, iv, 0x142, 0xa, 0xf, false);
    else t = __builtin_amdgcn_update_dpp(0, iv, 0x143, 0xc, 0xf, false);
    return v + __int_as_float(t);
}
__device__ __forceinline__ float wave_incl_scan(float v) { v = dpp_add_(v, 0); v = dpp_add_(v, 1); v = dpp_add_(v, 2); v = dpp_add_(v, 3); v = dpp_add_(v, 4); v = dpp_add_(v, 5); return v; }
__device__ __forceinline__ float dpp_mul_(float v, const int ctrl_sel) {
    int t; const int iv = __float_as_int(v), one = 0x3f800000;
    if (ctrl_sel == 0) t = __builtin_amdgcn_update_dpp(one, iv, 0x111, 0xf, 0xf, false);
    else if (ctrl_sel == 1) t = __builtin_amdgcn_update_dpp(one, iv, 0x112, 0xf, 0xf, false);
    else if (ctrl_sel == 2) t = __builtin_amdgcn_update_dpp(one, iv, 0x114, 0xf, 0xf, false);
    else if (ctrl_sel == 3) t = __builtin_amdgcn_update_dpp(one, iv, 0x118, 0xf, 0xf, false);
    else if (ctrl_sel == 4) t = __builtin_amdgcn_update_dpp(one, iv, 0x142, 0xa, 0xf, false);
    else t = __builtin_amdgcn_update_dpp(one, iv, 0x143, 0xc, 0xf, false);
    return v * __int_as_float(t);
}
__device__ __forceinline__ float wave_incl_prod(float v) { v = dpp_mul_(v, 0); v = dpp_mul_(v, 1); v = dpp_mul_(v, 2); v = dpp_mul_(v, 3); v = dpp_mul_(v, 4); v = dpp_mul_(v, 5); return v; }
__device__ __forceinline__ float rdlane(float v, int l) { return __int_as_float(__builtin_amdgcn_readlane(__float_as_int(v), l)); }

__device__ __forceinline__ void hgrn_unit(const P& p, LAS unsigned char* lds, int u) {
    int tid_ = threadIdx.x; asm volatile("" : "+v"(tid_));
    const int tid = tid_, w = __builtin_amdgcn_readfirstlane(tid >> 6), lane = tid & 63, i = lane & 15, g = lane >> 4;
    {
        const int dir = u & 1, h = (u >> 1) & 3, b = u >> 3;
        float lbv[16];
#pragma unroll
        for (int dd = 0; dd < 16; ++dd) { const float* lbp = dir ? p.lb_b : p.lb_f; const float a0 = lbp[h * 128 + 16 * w + dd], a1 = lbp[DG + h * 128 + 16 * w + dd], mx = fmaxf(a0, a1);
            const float e0 = __expf(a0 - mx), e1 = __expf(a1 - mx); lbv[dd] = e0 / (e0 + e1); }
        const int tokb = b * L;
        const int qoff = h * 128 + 16 * w, foff = (dir ? 1024 : 512) + h * 128 + 16 * w, voff = 1536 + h * 128 + 16 * w;
        bf16* po = p.o + ((size_t)dir * NTOK + (size_t)b * L) * DG + h * 128;
        f32x4 S[8];
#pragma unroll
        for (int vi = 0; vi < 8; ++vi) S[vi] = (f32x4){0.f, 0.f, 0.f, 0.f};
        __syncthreads();
        u32x4 rq0, rq1, rf0, rf1, rv0, rv1;
#define HG_TOK(m, j) (dir ? 64 * (m) + 15 - (j) : 64 * (m) - 48 + (j))
#define HG_LOADRAW(m) do { const int t_ = HG_TOK(m, lane); rq0 = rq1 = rf0 = rf1 = rv0 = rv1 = (u32x4){0u, 0u, 0u, 0u}; \
            if (t_ >= 0) { const bf16* r_ = p.pg + blk16(tokb + t_, 0, NHG / 16); rq0 = *(const u32x4*)(r_ + (qoff >> 4) * 256); rq1 = *(const u32x4*)(r_ + (qoff >> 4) * 256 + 8); \
                           rf0 = *(const u32x4*)(r_ + (foff >> 4) * 256); rf1 = *(const u32x4*)(r_ + (foff >> 4) * 256 + 8); rv0 = *(const u32x4*)(r_ + (voff >> 4) * 256); rv1 = *(const u32x4*)(r_ + (voff >> 4) * 256 + 8); } } while (0)
        HG_LOADRAW(dir ? 32 : 0);
        for (int n = 0; n < 33; ++n) {
            const int m = dir ? 32 - n : n;
            {
                const bool valid = HG_TOK(m, lane) >= 0;
                const unsigned qw[8] = {rq0.x, rq0.y, rq0.z, rq0.w, rq1.x, rq1.y, rq1.z, rq1.w}, fw[8] = {rf0.x, rf0.y, rf0.z, rf0.w, rf1.x, rf1.y, rf1.z, rf1.w};
                float qsv[16], ksv[16]; float decv = 0.f;
#pragma unroll
                for (int dd = 0; dd < 16; ++dd) {
                    const float qr = (dd & 1) ? bfhi(qw[dd >> 1]) : bflo(qw[dd >> 1]), fr_ = (dd & 1) ? bfhi(fw[dd >> 1]) : bflo(fw[dd >> 1]);
                    const float qq = qr * __builtin_amdgcn_rcpf(1.0f + __builtin_amdgcn_exp2f(-1.44269504f * qr)), fl = __builtin_amdgcn_rcpf(1.0f + __builtin_amdgcn_exp2f(-1.44269504f * fr_));
                    const float f = valid ? lbv[dd] + (1.0f - lbv[dd]) * fl : 1.0f, k = 1.0f - f;
                    const float Pj = wave_incl_prod(f), P63 = rdlane(Pj, 63);
                    qsv[dd] = qq * Pj; ksv[dd] = k * __builtin_amdgcn_rcpf(Pj);
                    *(LAS bf16*)(lds + HG_KDT + (16 * w + dd) * HG_RS64 + lane * 2) = f2bf(ksv[dd] * P63);
                    decv = (lane == dd) ? P63 : decv;
                }
                u32x4 o0, o1;
#define HG_PK(arr, dst) o0.x = cvt_pk_bf16(arr[0], arr[1]); o0.y = cvt_pk_bf16(arr[2], arr[3]); o0.z = cvt_pk_bf16(arr[4], arr[5]); o0.w = cvt_pk_bf16(arr[6], arr[7]); \
                        o1.x = cvt_pk_bf16(arr[8], arr[9]); o1.y = cvt_pk_bf16(arr[10], arr[11]); o1.z = cvt_pk_bf16(arr[12], arr[13]); o1.w = cvt_pk_bf16(arr[14], arr[15]); \
                        *(LAS u32x4*)(lds + (dst) + lane * HG_RS + 32 * w) = o0; *(LAS u32x4*)(lds + (dst) + lane * HG_RS + 32 * w + 16) = o1;
                HG_PK(qsv, HG_QS) HG_PK(ksv, HG_KS)
#undef HG_PK
                if (lane < 16) *(LAS float*)(lds + HG_DEC + (16 * w + lane) * 4) = decv;
                const unsigned vw[8] = {rv0.x, rv0.y, rv0.z, rv0.w, rv1.x, rv1.y, rv1.z, rv1.w};
#pragma unroll
                for (int e = 0; e < 16; ++e) *(LAS bf16*)(lds + HG_VT + (16 * w + e) * HG_RS64 + lane * 2) = (bf16)((e & 1) ? (vw[e >> 1] >> 16) : (vw[e >> 1] & 0xffffu));
            }
            if (n + 1 < 33) { const int mn = dir ? 31 - n : n + 1; HG_LOADRAW(mn); }
            __syncthreads();
            {
#pragma unroll
                for (int vi = 0; vi < 8; ++vi) { const f32x4 sv = S[vi]; u32x2 o; o.x = cvt_pk_bf16(sv[0], sv[1]); o.y = cvt_pk_bf16(sv[2], sv[3]); *(LAS u32x2*)(lds + HG_ST + (16 * vi + i) * HG_RS + (16 * w + 4 * g) * 2) = o; }
            }
            {
                const int si = w >> 1, tp = (w & 1) * 2;
                f32x4 sa[2] = {(f32x4){0.f, 0.f, 0.f, 0.f}, (f32x4){0.f, 0.f, 0.f, 0.f}};
#pragma unroll
                for (int kk = 0; kk < 4; ++kk) {
                    const bf16x8 A = *(const LAS bf16x8*)(lds + HG_KS + (16 * si + i) * HG_RS + (32 * kk + 8 * g) * 2);
#pragma unroll
                    for (int q = 0; q < 2; ++q) { const bf16x8 B = *(const LAS bf16x8*)(lds + HG_QS + (16 * (tp + q) + i) * HG_RS + (32 * kk + 8 * g) * 2); sa[q] = __builtin_amdgcn_mfma_f32_16x16x32_bf16(A, B, sa[q], 0, 0, 0); }
                }
#pragma unroll
                for (int q = 0; q < 2; ++q) {
                    const int t = 16 * (tp + q) + i, s0 = 16 * si + 4 * g;
                    u32x2 o; o.x = cvt_pk_bf16(s0 <= t ? sa[q][0] : 0.f, s0 + 1 <= t ? sa[q][1] : 0.f); o.y = cvt_pk_bf16(s0 + 2 <= t ? sa[q][2] : 0.f, s0 + 3 <= t ? sa[q][3] : 0.f);
                    *(LAS u32x2*)(lds + HG_SC + t * HG_RS64 + s0 * 2) = o;
                }
            }
            __syncthreads();
            {
                f32x4 oa[4];
#pragma unroll
                for (int q = 0; q < 4; ++q) oa[q] = (f32x4){0.f, 0.f, 0.f, 0.f};
#pragma unroll
                for (int kk = 0; kk < 2; ++kk) {
                    const bf16x8 A = *(const LAS bf16x8*)(lds + HG_VT + (16 * w + i) * HG_RS64 + (32 * kk + 8 * g) * 2);
#pragma unroll
                    for (int q = 0; q < 4; ++q) { const bf16x8 B = *(const LAS bf16x8*)(lds + HG_SC + (16 * q + i) * HG_RS64 + (32 * kk + 8 * g) * 2); oa[q] = __builtin_amdgcn_mfma_f32_16x16x32_bf16(A, B, oa[q], 0, 0, 0); }
                }
#pragma unroll
                for (int kk = 0; kk < 4; ++kk) {
                    const bf16x8 A = *(const LAS bf16x8*)(lds + HG_ST + (16 * w + i) * HG_RS + (32 * kk + 8 * g) * 2);
#pragma unroll
                    for (int q = 0; q < 4; ++q) { const bf16x8 B = *(const LAS bf16x8*)(lds + HG_QS + (16 * q + i) * HG_RS + (32 * kk + 8 * g) * 2); oa[q] = __builtin_amdgcn_mfma_f32_16x16x32_bf16(A, B, oa[q], 0, 0, 0); }
                }
#pragma unroll
                for (int q = 0; q < 4; ++q) {
                    const int t = HG_TOK(m, 16 * q + i);
                    if (t >= 0) { u32x2 o; o.x = cvt_pk_bf16(oa[q][0], oa[q][1]); o.y = cvt_pk_bf16(oa[q][2], oa[q][3]); *(u32x2*)(po + (size_t)t * DG + 16 * w + 4 * g) = o; }
                }
            }
            {
                const f32x4 dv = *(const LAS f32x4*)(lds + HG_DEC + (16 * w + 4 * g) * 4);
#pragma unroll
                for (int vi = 0; vi < 8; ++vi) S[vi] = S[vi] * dv;
#pragma unroll
                for (int kk = 0; kk < 2; ++kk) {
                    const bf16x8 A = *(const LAS bf16x8*)(lds + HG_KDT + (16 * w + i) * HG_RS64 + (32 * kk + 8 * g) * 2);
#pragma unroll
                    for (int vi = 0; vi < 8; ++vi) { const bf16x8 B = *(const LAS bf16x8*)(lds + HG_VT + (16 * vi + i) * HG_RS64 + (32 * kk + 8 * g) * 2); S[vi] = __builtin_amdgcn_mfma_f32_16x16x32_bf16(A, B, S[vi], 0, 0, 0); }
                }
            }
            __syncthreads();
        }
#undef HG_TOK
#undef HG_LOADRAW
    }
}
__device__ __forceinline__ void ph_mixers(const P& p, LAS unsigned char* lds, LAS int* ticket) {
    if ((blockIdx.x & 1) == 0) for (int u = blockIdx.x >> 1; u < BATCH * 8; u += (gridDim.x + 1) >> 1) hgrn_unit(p, lds, u);
    for (;;) {
        __syncthreads();
        if (threadIdx.x == 0) *ticket = (int)atomicAdd(p.cnt + 64, 1u);
        __syncthreads();
        const int c = *ticket;
        if (c >= DH) break;
        hyena_channel(p, lds, c);
    }
    if (blockIdx.x & 1) ph_conv_pair<2>(p, (float*)(void*)lds, 4, 16);
    __syncthreads();
}

__device__ __forceinline__ void ph_filters(const P& p, float* sm) {
    float* z = sm; float* h1 = sm + 8 * 33; float* h2 = h1 + 8 * 64;
    int tid_ = threadIdx.x; asm volatile("" : "+v"(tid_));
    const int tid = tid_;
    for (int un = blockIdx.x; un < (L / 8) * 4; un += gridDim.x) {
        const int grp = un >> 2, nq = un & 3, j0 = grp * 8;
        __syncthreads();
        if (tid < 8 * 33) {
            const int lg = tid / 33, ft = tid % 33, j = j0 + lg; float v;
            if (ft == 0) v = (float)((double)j / (double)(L - 1));
            else { const int ib = (ft - 1) & 15; const double band = 1e-4 + (double)ib * ((double)(15) - 1e-4) / 15.0; double turns = (double)j * band / (double)L; turns -= floor(turns);
                   const float ang = 6.28318530717958647692f * (float)turns;
                   v = ft <= 16 ? cosf(ang) : -sinf(ang); }
            z[tid] = v;
        }
        __syncthreads();
        { const int lg = tid >> 6, hc = tid & 63; float a = p.fb1[hc];
#pragma unroll
          for (int q = 0; q < 33; ++q) a += z[lg * 33 + q] * p.fw1[q * 64 + hc];
          h1[tid] = sinf(p.ffreq[hc] * a); }
        __syncthreads();
        { const int lg = tid >> 6, hc = tid & 63; float a = p.fb2[hc];
#pragma unroll 16
          for (int q = 0; q < 64; ++q) a += h1[lg * 64 + q] * p.fw2[q * 64 + hc];
          h2[tid] = sinf(p.ffreq[hc] * a); }
        __syncthreads();
        {
            const int n = nq * 512 + tid;
            float acc[8];
#pragma unroll
            for (int lg = 0; lg < 8; ++lg) acc[lg] = 0.f;
#pragma unroll 4
            for (int q4 = 0; q4 < 16; ++q4) { const float w0 = p.fw3[(4 * q4) * 2048 + n], w1 = p.fw3[(4 * q4 + 1) * 2048 + n], w2 = p.fw3[(4 * q4 + 2) * 2048 + n], w3 = p.fw3[(4 * q4 + 3) * 2048 + n];
#pragma unroll
                for (int lg = 0; lg < 8; ++lg) { const float4 hv = *(const float4*)(h2 + lg * 64 + 4 * q4); acc[lg] += (hv.x * w0 + hv.y * w1) + (hv.z * w2 + hv.w * w3); } }
            const int dir = n >> 10, order = (n >> 9) & 1, c = n & 511;
            const float lo = -3.0701134573f  , hi = -15.3505672866f  ;
            const float delta = fabsf(lo + (hi - lo) * (float)c * (1.0f / 511.0f));
            bf16* gp = p.G + ((size_t)order * 512 + c) * GL;
            bf16 ov[8];
#pragma unroll
            for (int lg = 0; lg < 8; ++lg) ov[lg] = f2bf(acc[lg] * __expf(-z[lg * 33] * delta));
            if (dir == 0) {
                u32x4 o; o.x = (unsigned)ov[7] | ((unsigned)ov[6] << 16); o.y = (unsigned)ov[5] | ((unsigned)ov[4] << 16); o.z = (unsigned)ov[3] | ((unsigned)ov[2] << 16); o.w = (unsigned)ov[1] | ((unsigned)ov[0] << 16);
                *(u32x4*)(gp + (L - 8 - j0)) = o;
            } else {
#pragma unroll
                for (int lg = 0; lg < 8; ++lg) if (j0 + lg >= 1) gp[L - 1 + j0 + lg] = ov[lg];
            }
        }
    }
    for (int x = blockIdx.x * blockDim.x + tid; x < 1024 * (GL - (2 * L - 1)); x += gridDim.x * blockDim.x) {
        const int row = x / (GL - (2 * L - 1)), m = (2 * L - 1) + x % (GL - (2 * L - 1));
        p.G[(size_t)row * GL + m] = 0;
    }
    __syncthreads();
}

constexpr int BA_RS = 1040;
__device__ __forceinline__ void ph_buildA2(const P& p, LAS unsigned char* lds) {
    int tid_ = threadIdx.x; asm volatile("" : "+v"(tid_));
    const int tid = tid_, w = __builtin_amdgcn_readfirstlane(tid >> 6), lane = tid & 63;
    float hyn[8], hgn[8];
#pragma unroll
    for (int e = 0; e < 8; ++e) { hyn[e] = p.hy_norm[8 * lane + e]; hgn[e] = p.hg_norm[8 * lane + e]; }
    for (int u = blockIdx.x; u < BATCH * (SEQ / 64); u += gridDim.x) {
        const int b = u / (SEQ / 64), tt = u % (SEQ / 64), t0 = NMETA + 64 * tt;
        __syncthreads();
        {
            const bf16* src = p.z2 + ((size_t)tid * BATCH + b) * LP + t0;
            u32x4 v[8];
#pragma unroll
            for (int q = 0; q < 8; ++q) v[q] = *(const u32x4*)(src + 8 * q);
#pragma unroll
            for (int q = 0; q < 8; ++q) {
                const unsigned wv[4] = {v[q].x, v[q].y, v[q].z, v[q].w};
#pragma unroll
                for (int e = 0; e < 8; ++e) *(LAS bf16*)(lds + (8 * q + e) * BA_RS + tid * 2) = (bf16)((e & 1) ? (wv[e >> 1] >> 16) : (wv[e >> 1] & 0xffffu));
            }
        }
        __syncthreads();
#pragma unroll 2
        for (int jt = 8 * w; jt < 8 * w + 8; ++jt) {
            const size_t tok = (size_t)b * L + t0 + jt; bf16* dst = p.A + ((size_t)b * SEQ + 64 * tt + jt) * D;
            const u32x4 zv = *(const LAS u32x4*)(lds + jt * BA_RS + lane * 16);
            const u32x4 of = *(const u32x4*)(p.o + tok * DG + 8 * lane), ob = *(const u32x4*)(p.o + ((size_t)NTOK + tok) * DG + 8 * lane), gv = *(const u32x4*)(p.pg + blk16((int)tok, 2048 + 8 * lane, NHG / 16));
            float z[8] = {bflo(zv.x), bfhi(zv.x), bflo(zv.y), bfhi(zv.y), bflo(zv.z), bfhi(zv.z), bflo(zv.w), bfhi(zv.w)};
            float ss = 0.f;
#pragma unroll
            for (int e = 0; e < 8; ++e) ss += z[e] * z[e];
            ss = wave_sum(ss);
            const float r = rsqrtf(ss * (1.0f / DH) + EPS);
            u32x4 o; o.x = cvt_pk_bf16(z[0] * r * hyn[0], z[1] * r * hyn[1]); o.y = cvt_pk_bf16(z[2] * r * hyn[2], z[3] * r * hyn[3]);
            o.z = cvt_pk_bf16(z[4] * r * hyn[4], z[5] * r * hyn[5]); o.w = cvt_pk_bf16(z[6] * r * hyn[6], z[7] * r * hyn[7]);
            *(u32x4*)(dst + 8 * lane) = o;
            float ov[8] = {bflo(of.x) + bflo(ob.x), bfhi(of.x) + bfhi(ob.x), bflo(of.y) + bflo(ob.y), bfhi(of.y) + bfhi(ob.y), bflo(of.z) + bflo(ob.z), bfhi(of.z) + bfhi(ob.z), bflo(of.w) + bflo(ob.w), bfhi(of.w) + bfhi(ob.w)};
            const float gg[8] = {bflo(gv.x), bfhi(gv.x), bflo(gv.y), bfhi(gv.y), bflo(gv.z), bfhi(gv.z), bflo(gv.w), bfhi(gv.w)};
            float hs = 0.f;
#pragma unroll
            for (int e = 0; e < 8; ++e) hs += ov[e] * ov[e];
            hs += __shfl_xor(hs, 1); hs += __shfl_xor(hs, 2); hs += __shfl_xor(hs, 4); hs += __shfl_xor(hs, 8);
            const float hr = rsqrtf(hs * (1.0f / 128.0f) + EPS);
            float y[8];
#pragma unroll
            for (int e = 0; e < 8; ++e) y[e] = ov[e] * hr * hgn[e] * siluf_(gg[e]);
            u32x4 o2; o2.x = cvt_pk_bf16(y[0], y[1]); o2.y = cvt_pk_bf16(y[2], y[3]); o2.z = cvt_pk_bf16(y[4], y[5]); o2.w = cvt_pk_bf16(y[6], y[7]);
            *(u32x4*)(dst + DH + 8 * lane) = o2;
        }
    }
    __syncthreads();
}

__device__ __forceinline__ void ph_conv_router(const P& p) {
    for (int idx = blockIdx.x * blockDim.x + threadIdx.x; idx < 80 * 1024; idx += gridDim.x * blockDim.x) {
        const int n = idx >> 10, k = idx & 1023;
        const float wv = (n < 8 ? p.w_rg[k * 8 + n] : (n < 72 ? p.w_re[k * 64 + (n - 8)] : 0.f)) * p.norm_ffn[k];
        const bf16 hi = f2bf(wv); p.Wr[idx] = hi; p.Wr[80 * 1024 + idx] = f2bf(wv - bf2f(hi));
    }
}
template <bool DRY>
__device__ __forceinline__ void ph_router(const P& p, LAS unsigned char* lds) {
    int tid_ = threadIdx.x; asm volatile("" : "+v"(tid_));
    const int tid = tid_, w = __builtin_amdgcn_readfirstlane(tid >> 6), lane = tid & 63, i = lane & 15, g = lane >> 4;
    LAS float* lg = (LAS float*)lds + w * (16 * 81 + 16);
    LAS int* lcnt = (LAS int*)(lds + 8 * (16 * 81 + 16) * 4);
    constexpr int RT_WB = 8 * (16 * 81 + 16) * 4 + 1024;
    for (int tile = blockIdx.x; tile < NX / 128; tile += gridDim.x) {
        __syncthreads();
        if (tid < 64) lcnt[tid] = 0;
        __syncthreads();
        const int xr0 = tile * 128 + w * 16;
        const bf16* hrow = p.h1 + (size_t)(xr0 + i) * D + 8 * g;
        f32x4 acc[5];
#pragma unroll
        for (int nt = 0; nt < 5; ++nt) acc[nt] = (f32x4){0.f, 0.f, 0.f, 0.f};
        float ss = 0.f;
        for (int kc = 0; kc < 4; ++kc) {
            __syncthreads();
            for (int x = tid; x < 2 * 80 * 32; x += 512) { const int pl = x / 2560, rem = x % 2560, n = rem >> 5, c16 = rem & 31;
                *(LAS u32x4*)(lds + RT_WB + (pl * 80 + n) * 528 + c16 * 16) = *(const u32x4*)(p.Wr + (size_t)pl * 80 * 1024 + (size_t)n * 1024 + kc * 256 + c16 * 8); }
            __syncthreads();
#pragma unroll 4
            for (int k8 = 0; k8 < 8; ++k8) {
                const u32x4 hv = *(const u32x4*)(hrow + kc * 256 + 32 * k8);
                const float h0 = bflo(hv.x), h1_ = bfhi(hv.x), h2 = bflo(hv.y), h3 = bfhi(hv.y), h4 = bflo(hv.z), h5 = bfhi(hv.z), h6 = bflo(hv.w), h7 = bfhi(hv.w);
                ss += (h0 * h0 + h1_ * h1_) + (h2 * h2 + h3 * h3) + (h4 * h4 + h5 * h5) + (h6 * h6 + h7 * h7);
                const bf16x8 Ah = __builtin_bit_cast(bf16x8, hv);
#pragma unroll
                for (int nt = 0; nt < 5; ++nt) {
                    const bf16x8 bh = *(const LAS bf16x8*)(lds + RT_WB + (16 * nt + i) * 528 + (32 * k8 + 8 * g) * 2), bl = *(const LAS bf16x8*)(lds + RT_WB + (80 + 16 * nt + i) * 528 + (32 * k8 + 8 * g) * 2);
                    acc[nt] = __builtin_amdgcn_mfma_f32_16x16x32_bf16(Ah, bh, acc[nt], 0, 0, 0);
                    acc[nt] = __builtin_amdgcn_mfma_f32_16x16x32_bf16(Ah, bl, acc[nt], 0, 0, 0);
                }
            }
        }
        ss += __shfl_xor(ss, 16); ss += __shfl_xor(ss, 32);
        if (g == 0) lg[16 * 81 + i] = rsqrtf(ss * (1.0f / D) + EPS);
#pragma unroll
        for (int nt = 0; nt < 5; ++nt)
#pragma unroll
            for (int r = 0; r < 4; ++r) lg[(4 * g + r) * 81 + 16 * nt + i] = acc[nt][r];
        asm volatile("s_waitcnt lgkmcnt(0)" ::: "memory");
        int x0 = 0, x1 = 0, l0 = 0, l1 = 0; float gate0 = 0.f, gate1 = 0.f, rs = 0.f;
        if (lane < 16) {
            const LAS float* row = lg + lane * 81; rs = lg[16 * 81 + lane];
            float lgv[8];
#pragma unroll
            for (int q = 0; q < 8; ++q) lgv[q] = row[q] * rs;
            int gs = 0; float best = lgv[0];
#pragma unroll
            for (int q = 1; q < 8; ++q) if (lgv[q] > best) { best = lgv[q]; gs = q; }
            float den = 0.f;
#pragma unroll
            for (int q = 0; q < 8; ++q) den += __expf(lgv[q] - best);
            const float pgroup = 1.0f / den;
            float le[8];
#pragma unroll
            for (int q = 0; q < 8; ++q) le[q] = row[8 + gs * 8 + q] * rs;
            int e0 = 0; float b0 = le[0];
#pragma unroll
            for (int q = 1; q < 8; ++q) if (le[q] > b0) { b0 = le[q]; e0 = q; }
            int e1 = -1; float b1 = -3.0e38f;
#pragma unroll
            for (int q = 0; q < 8; ++q) if (q != e0 && le[q] > b1) { b1 = le[q]; e1 = q; }
            const float q1 = __expf(b1 - b0), inv = 1.0f / (1.0f + q1);
            x0 = gs * 8 + e0; x1 = gs * 8 + e1; gate0 = pgroup * inv; gate1 = pgroup * q1 * inv;
            if (!DRY) { l0 = atomicAdd((int*)(lcnt + x0), 1); l1 = atomicAdd((int*)(lcnt + x1), 1); }
        }
        __syncthreads();
        if (!DRY && tid < 64) { const int c = lcnt[tid]; lcnt[64 + tid] = c ? (int)atomicAdd(p.cnt + tid, (unsigned)c) : 0; }
        __syncthreads();
        if (!DRY && lane < 16) {
            const int xr = xr0 + lane, r0 = lcnt[64 + x0] + l0, r1 = lcnt[64 + x1] + l1;
            p.rstd[xr] = rs;
            p.list[(size_t)x0 * NX + r0] = xr; p.list[(size_t)x1 * NX + r1] = xr; p.rsl[(size_t)x0 * NX + r0] = rs; p.rsl[(size_t)x1 * NX + r1] = rs;
            p.asg_e[xr * 2] = x0; p.asg_e[xr * 2 + 1] = x1; p.asg_rank[xr * 2] = r0; p.asg_rank[xr * 2 + 1] = r1;
            p.asg_gate[xr * 2] = gate0; p.asg_gate[xr * 2 + 1] = gate1;
        }
    }
    __syncthreads();
}

__device__ __forceinline__ void moe_tables(const P& p, int* tb) {
    __syncthreads();
    if (threadIdx.x < NE) tb[threadIdx.x] = (int)xb_ld(p.cnt + threadIdx.x);
    __syncthreads();
    if (threadIdx.x == 0) {
        int s = 0, nt = 0;
        for (int e = 0; e < NE; ++e) { const int c = tb[e]; tb[64 + e] = s;
            for (int j = 0; j < (c + 255) / 256; ++j) { tb[192 + nt] = e; tb[512 + nt] = j * 256; ++nt; }
            s += (c + 255) / 256 * 256; }
        tb[128] = s; tb[129] = nt;
    }
    __syncthreads();
}
struct MoeOrder { const int* tb; int G, c;
    __device__ __forceinline__ bool next(int i, Unit& u) const {
        int rt, pn;
        if ((G & 31) == 0) { const int x = c & 7, q = c >> 3; rt = i * (G >> 2) + x * (G >> 5) + (q >> 2); pn = q & 3; }
        else { const int Lx = i * G + c; rt = Lx >> 2; pn = Lx & 3; }
        if (rt >= tb[129]) return false;
        u.pm = rt; u.pn = pn; u.e = tb[192 + rt]; u.r0 = tb[512 + rt]; return true; } };
struct GMoe1 { const char* A; int kstepA, K; const char* Bt; const int* list; const int* tb;
    __device__ __forceinline__ unsigned aoff(const Unit& u, int r, int C) const { const int rr = u.r0 + r; const int xr = rr < tb[u.e] ? list[(size_t)u.e * NX + rr] : 0; return (unsigned)xr * (D * 2) + (unsigned)(C * 2); }
    __device__ __forceinline__ const char* bptr(const Unit& u) const { return Bt + ((size_t)u.e * 1024 + (size_t)u.pn * BM) * D * 2; } };
struct EpiMoe1 { static constexpr int KIND = 3; bf16* hid; const float* rsl; const int* tb;
    __device__ __forceinline__ void operator()(const f32x4 (&acc)[2][2][4][2], const Unit& u, int wr, int wc, int fr, int fq) const {
        const int cnt = tb[u.e], s0 = tb[64 + u.e] + u.r0;
#pragma unroll
        for (int ai = 0; ai < 2; ++ai)
#pragma unroll
            for (int m = 0; m < 4; ++m) { const int r = ai * HALF + wr * 64 + m * 16 + fr, rr = u.r0 + r; const float rs = rr < cnt ? rsl[(size_t)u.e * NX + rr] : 0.f;
#pragma unroll
                for (int n = 0; n < 2; ++n) { const f32x4 gt = acc[ai][0][m][n] * rs, up = acc[ai][1][m][n] * rs; uint2 o;
                    o.x = cvt_pk_bf16(siluf_(gt[0]) * up[0], siluf_(gt[1]) * up[1]); o.y = cvt_pk_bf16(siluf_(gt[2]) * up[2], siluf_(gt[3]) * up[3]); *(uint2*)(hid + blk16(s0 + r, u.pn * HALF + wc * 32 + n * 16 + 4 * fq, DE / 16)) = o; } }
    } };
__device__ __forceinline__ void ph_moe1(const P& p, LAS unsigned char* lds, const int* tb) {
    GMoe1 g{(const char*)p.h1, BK * 2, D, (const char*)p.Wgu, p.list, tb}; MoeOrder S{tb, (int)gridDim.x, (int)blockIdx.x}; EpiMoe1 E{p.hid, p.rsl, tb};
    gemm_phase(lds, g, S, E);
}
struct GMoe2 { const char* A; int kstepA, K; const char* Bt; const int* tb;
    __device__ __forceinline__ unsigned aoff(const Unit& u, int r, int C) const { return (unsigned)(blk16(tb[64 + u.e] + u.r0 + r, C, DE / 16) * 2); }
    __device__ __forceinline__ const char* bptr(const Unit& u) const { return Bt + ((size_t)u.e * 1024 + (size_t)u.pn * BM) * DE * 2; } };
struct EpiMoe2 { static constexpr int KIND = 4; bf16* y; const int* tb;
    __device__ __forceinline__ void operator()(const f32x4 (&acc)[2][2][4][2], const Unit& u, int wr, int wc, int fr, int fq) const {
        const int s0 = tb[64 + u.e] + u.r0;
#pragma unroll
        for (int ai = 0; ai < 2; ++ai)
#pragma unroll
            for (int m = 0; m < 4; ++m) { const int row = s0 + ai * HALF + wr * 64 + m * 16 + fr, col0 = u.pn * BM + wc * 32 + 4 * fq;
#pragma unroll
                for (int bj = 0; bj < 2; ++bj)
#pragma unroll
                    for (int n = 0; n < 2; ++n) { const f32x4 v = acc[ai][bj][m][n]; uint2 o; o.x = cvt_pk_bf16(v[0], v[1]); o.y = cvt_pk_bf16(v[2], v[3]); *(uint2*)(y + (size_t)row * D + col0 + bj * HALF + n * 16) = o; } }
    } };
__device__ __forceinline__ void ph_moe2(const P& p, LAS unsigned char* lds, const int* tb) {
    GMoe2 g{(const char*)p.hid, 4 * 512, DE, (const char*)p.Wd, tb}; MoeOrder S{tb, (int)gridDim.x, (int)blockIdx.x}; EpiMoe2 E{p.y, tb};
    gemm_phase(lds, g, S, E);
}
__device__ __forceinline__ void ph_final(const P& p, const int* tb) {
    const int* soff = tb + 64;
    int tid_ = threadIdx.x; asm volatile("" : "+v"(tid_));
    const int lane = tid_ & 63, wpb = blockDim.x >> 6;
    const int wave = blockIdx.x * wpb + (tid_ >> 6), nw = gridDim.x * wpb;
    float gn[16];
#pragma unroll
    for (int q = 0; q < 4; ++q) { const float4 g4 = ((const float4*)p.norm_final)[lane * 4 + q]; gn[4 * q] = g4.x; gn[4 * q + 1] = g4.y; gn[4 * q + 2] = g4.z; gn[4 * q + 3] = g4.w; }
    const bool bad = xb_ld(p.bar + XB_TMO) != 0u;
    for (int xr0 = wave; xr0 < NX; xr0 += 2 * nw) {
        const int xrs[2] = {xr0, xr0 + nw < NX ? xr0 + nw : xr0};
        u32x4 hv[2][2], av[2][2], cv[2][2]; float g0[2], g1[2];
#pragma unroll
        for (int q = 0; q < 2; ++q) {
            const int xr = xrs[q];
            const int s0 = soff[p.asg_e[xr * 2]] + p.asg_rank[xr * 2], s1 = soff[p.asg_e[xr * 2 + 1]] + p.asg_rank[xr * 2 + 1];
            g0[q] = p.asg_gate[xr * 2]; g1[q] = p.asg_gate[xr * 2 + 1];
            const bf16* hp = p.h1 + (size_t)xr * D + 16 * lane; const bf16* y0 = p.y + (size_t)s0 * D + 16 * lane; const bf16* y1 = p.y + (size_t)s1 * D + 16 * lane;
            hv[q][0] = *(const u32x4*)hp; hv[q][1] = *(const u32x4*)(hp + 8); av[q][0] = *(const u32x4*)y0; av[q][1] = *(const u32x4*)(y0 + 8); cv[q][0] = *(const u32x4*)y1; cv[q][1] = *(const u32x4*)(y1 + 8);
        }
#pragma unroll
        for (int q = 0; q < 2; ++q) {
            float v[16]; float ss = 0.f;
#pragma unroll
            for (int hq = 0; hq < 2; ++hq) {
                const unsigned hw[4] = {hv[q][hq].x, hv[q][hq].y, hv[q][hq].z, hv[q][hq].w}, aw[4] = {av[q][hq].x, av[q][hq].y, av[q][hq].z, av[q][hq].w}, cw[4] = {cv[q][hq].x, cv[q][hq].y, cv[q][hq].z, cv[q][hq].w};
#pragma unroll
                for (int e = 0; e < 4; ++e) { v[8 * hq + 2 * e] = bflo(hw[e]) + g0[q] * bflo(aw[e]) + g1[q] * bflo(cw[e]); v[8 * hq + 2 * e + 1] = bfhi(hw[e]) + g0[q] * bfhi(aw[e]) + g1[q] * bfhi(cw[e]); }
            }
#pragma unroll
            for (int e = 0; e < 16; ++e) ss += v[e] * v[e];
            ss = wave_sum(ss);
            float r = rsqrtf(ss * (1.0f / D) + EPS);
            if (bad) r = __builtin_nanf("");
            float* op = p.out + (size_t)xrs[q] * D + 16 * lane;
#pragma unroll
            for (int e4 = 0; e4 < 4; ++e4) *(float4*)(op + 4 * e4) = make_float4(v[4 * e4] * r * gn[4 * e4], v[4 * e4 + 1] * r * gn[4 * e4 + 1], v[4 * e4 + 2] * r * gn[4 * e4 + 2], v[4 * e4 + 3] * r * gn[4 * e4 + 3]);
        }
    }
}

constexpr int LDS_SCR = HY_END > STAGE_BYTES ? HY_END : STAGE_BYTES;
constexpr int LDS_BAR = LDS_SCR, LDS_TB = LDS_SCR + 64, LDS_BYTES = LDS_SCR + 64 + 4096;
static_assert(LDS_BYTES <= 160 * 1024 && HG_END <= LDS_SCR, "LDS");

__global__ void __launch_bounds__(512, 2) k_mega(P p) {
    extern __shared__ __attribute__((aligned(16))) unsigned char smraw[];
    float* sm = (float*)smraw;
    LAS unsigned char* lds = (LAS unsigned char*)smraw;
    int* tb = (int*)(smraw + LDS_TB);
    if (threadIdx.x == 0) *(uint4*)(smraw + LDS_BAR) = make_uint4(0u, 0u, 0u, 0u);
    __syncthreads();
    XcdBarrier bar = xcd_barrier_post(p.bar, (volatile LAS unsigned*)(smraw + LDS_BAR));
    ph_norm1(p);
    ph_conv<1>(p, sm, 0, 3);
    ph_conv_router(p);
    ph_filters(p, sm);
    xcd_barrier(bar);
    const int sg = (blockIdx.x >> 3) & 3;
    ph_conv<2>(p, sm, 0, (4 / 4) * sg);
    ph_inproj(p, lds);
    ph_conv<2>(p, sm, (4 / 4) * sg, 4);
    xcd_barrier(bar);
    ph_mixers(p, lds, (LAS int*)(smraw + LDS_TB));
    xcd_barrier(bar);
    ph_buildA2(p, lds);
    xcd_barrier(bar);
    ph_conv<0>(p, sm, 0, 8 * sg);
    ph_outproj(p, lds);
    ph_conv<0>(p, sm, 8 * sg, 1 << 20);
    xcd_barrier(bar);
    ph_router<false>(p, lds);
    xcd_barrier(bar);
    moe_tables(p, tb);
    ph_moe1(p, lds, tb);
    xcd_barrier(bar);
    ph_moe2(p, lds, tb);
    xcd_barrier(bar);
    ph_final(p, tb);
}

struct Alloc { size_t off = 0; size_t take(size_t bytes) { const size_t o = off; off += (bytes + 255) & ~(size_t)255; return o; } };
}

extern "C" void kernel_launch(void* const* d_in, const int* in_sizes, int n_in, void* d_out, int out_size, void* d_ws, size_t ws_size, hipStream_t stream) {
    (void)in_sizes; (void)n_in; (void)out_size;
    char* ws = (char*)d_ws;
    P p{};
    const float** ins[] = {&p.x, &p.meta, &p.w_in, &p.conv_w, &p.conv_b, &p.fw1, &p.fb1, &p.fw2, &p.fb2, &p.fw3, &p.ffreq, &p.fskip, &p.hy_norm, &p.lb_f, &p.lb_b,
                           &p.hg_norm, &p.w_out, &p.norm_mix, &p.norm_ffn, &p.w_rg, &p.w_re, &p.w_gate, &p.w_up, &p.w_down, &p.norm_final};
    for (int i = 0; i < 25; ++i) *ins[i] = (const float*)d_in[i];
    p.out = (float*)d_out;
    Alloc a;
    const size_t o_zero = a.take(65536);
    const size_t o_A = a.take((size_t)NX * D * 2);
    const size_t o_Preg = a.off;
    const size_t o_pT = a.take((size_t)NHY * BATCH * LP * 2);
    const size_t o_pg = a.take((size_t)NTOK * NHG * 2);
    const size_t o_G = a.take((size_t)1024 * GL * 2);
    const size_t o_W1t = a.take((size_t)NPROJ * D * 2);
    const size_t o_Hreg = a.off;
    const size_t o_z2 = a.take((size_t)DH * BATCH * LP * 2);
    const size_t o_o = a.take((size_t)2 * NTOK * DG * 2);
    if (a.off < o_Hreg + (size_t)NX * D * 2) a.off = o_Hreg + (size_t)NX * D * 2;
    const size_t o_W2t = a.take((size_t)D * D * 2);
    const size_t o_Wd = a.take((size_t)NE * 1024 * DE * 2);
    const size_t o_Wr = a.take((size_t)2 * 80 * 1024 * 2);
    const size_t o_Am = a.take((size_t)NMETA * D * 2);
    const size_t o_list = a.take((size_t)NE * NX * 4);
    const size_t o_rstd = a.take((size_t)NX * 4);
    const size_t o_rsl = a.take((size_t)NE * NX * 4);
    const size_t o_ae = a.take((size_t)NX * 2 * 4), o_ar = a.take((size_t)NX * 2 * 4), o_ag = a.take((size_t)NX * 2 * 4);
    const size_t sz_wgu = (size_t)NE * 1024 * 1024 * 2, sz_hid = (size_t)MAXSLOT * DE * 2, sz_wd = (size_t)NE * 1024 * DE * 2, sz_y = (size_t)MAXSLOT * D * 2;
    const size_t o_Wgu = o_Preg, o_hid = o_Wgu + sz_wgu, o_y = o_A, o_h1 = o_Hreg;
    (void)sz_wd;
    if (a.off > ws_size || o_hid + sz_hid > o_G || o_y + sz_y > o_Wgu + sz_wgu || o_h1 + (size_t)NX * D * 2 > o_W2t) {
        fprintf(stderr, "workspace map does not fit: need %zu have %zu\n", a.off, ws_size); return; }
    p.bar = (unsigned*)(ws + o_zero); p.cnt = p.bar + 8192;
    p.A = (bf16*)(ws + o_A); p.pT = (bf16*)(ws + o_pT); p.pg = (bf16*)(ws + o_pg); p.G = (bf16*)(ws + o_G); p.z2 = (bf16*)(ws + o_z2); p.o = (bf16*)(ws + o_o);
    p.h1 = (bf16*)(ws + o_h1); p.rstd = (float*)(ws + o_rstd); p.list = (int*)(ws + o_list); p.rsl = (float*)(ws + o_rsl); p.asg_e = (int*)(ws + o_ae); p.asg_rank = (int*)(ws + o_ar); p.asg_gate = (float*)(ws + o_ag);
    p.hid = (bf16*)(ws + o_hid); p.y = (bf16*)(ws + o_y);
    p.W1t = (bf16*)(ws + o_W1t); p.W2t = (bf16*)(ws + o_W2t); p.Wgu = (bf16*)(ws + o_Wgu); p.Wd = (bf16*)(ws + o_Wd); p.Wr = (bf16*)(ws + o_Wr); p.Am = (bf16*)(ws + o_Am);
    hipMemsetAsync(ws + o_zero, 0, 65536, stream);
    static int grid = 0;
    if (!grid) {
        int dev = 0, cus = 0, per_cu = 0;
        hipGetDevice(&dev);
        hipDeviceGetAttribute(&cus, hipDeviceAttributeMultiprocessorCount, dev);
        if (hipFuncSetAttribute((const void*)k_mega, hipFuncAttributeMaxDynamicSharedMemorySize, LDS_BYTES) != hipSuccess) { fprintf(stderr, "hipFuncSetAttribute failed\n"); return; }
        hipOccupancyMaxActiveBlocksPerMultiprocessor(&per_cu, (const void*)k_mega, 512, LDS_BYTES);
        if (per_cu < 1) { fprintf(stderr, "occupancy query says 0 blocks per CU\n"); return; }
        grid = cus;
    }
    k_mega<<<grid, 512, LDS_BYTES, stream>>>(p);
}
```

```cpp
#include <hip/hip_runtime.h>
#include <stdint.h>
#include <stdio.h>

namespace {
typedef unsigned short bf16;
constexpr int D = 1024, BATCH = 16, SEQ = 2048, NMETA = 16, L = SEQ + NMETA;
constexpr int NTOK = BATCH * L;
constexpr int NX = BATCH * SEQ;
constexpr int DH = 512, DG = 512, NHY = 1536, NHG = 2560, NPROJ = 4096;
constexpr int LP = 2080;
constexpr int GL = 4160;
constexpr int NE = 64, DE = 512;
constexpr int MAXSLOT = NX * 2 + NE * 256;
constexpr float EPS = 1e-6f;

__device__ __forceinline__ bf16 f2bf(float f) { unsigned u = __float_as_uint(f); u += 0x7FFFu + ((u >> 16) & 1u); return (bf16)(u >> 16); }
__device__ __forceinline__ float bf2f(bf16 b) { return __uint_as_float(((unsigned)b) << 16); }
__device__ __forceinline__ float wave_sum(float v) {
#pragma unroll
    for (int o = 32; o >= 1; o >>= 1) v += __shfl_xor(v, o);
    return v;
}
__device__ __forceinline__ float sigmoidf_(float x) { return 1.0f / (1.0f + __expf(-x)); }
__device__ __forceinline__ float siluf_(float x) { return x * __builtin_amdgcn_rcpf(1.0f + __builtin_amdgcn_exp2f(-1.44269504f * x)); }

#define XB_TMO      128
#define XB_XCNT(j)  (256  + 64 * (j))
#define XB_XSUB(j)  (1280 + 64 * (j))
#define XB_XGEN(j)  (2304 + 64 * (j))
#define XB_TOP      3328
#define XB_TOPGEN   3392
#define XCD_BAR_WORDS 3456
#define XB_SPIN_CAP (1u << 21)
#define LAS __attribute__((address_space(3)))

__device__ __forceinline__ unsigned xb_ld(unsigned* p)              { return __hip_atomic_load(p, __ATOMIC_RELAXED, __HIP_MEMORY_SCOPE_AGENT); }
__device__ __forceinline__ unsigned xb_add(unsigned* p, unsigned v) { return __hip_atomic_fetch_add(p, v, __ATOMIC_RELAXED, __HIP_MEMORY_SCOPE_AGENT); }
__device__ __forceinline__ unsigned xb_xcc_id() { return (unsigned)__builtin_amdgcn_s_getreg((3 << 11) | 20) & 0xFu; }
#define XB_SPIN(cond, bar) do { unsigned _sp = 0; while (cond) { __builtin_amdgcn_s_sleep(1); \
    if ((++_sp & 255u) == 0u) { if (xb_ld(&(bar)[XB_TMO])) break; if (_sp > XB_SPIN_CAP) { atomicAdd(&(bar)[XB_TMO], 1u); break; } } } } while (0)

struct XcdBarrier {
    unsigned* bar; unsigned x;
    volatile LAS unsigned* st;
};

__device__ __forceinline__ XcdBarrier xcd_barrier_post(unsigned* bar, volatile LAS unsigned* st) {
    XcdBarrier b; b.bar = bar; b.x = xb_xcc_id(); b.st = st;
    if (threadIdx.x == 0) (void)xb_add(&bar[XB_XCNT(b.x)], 1u);
    return b;
}
__device__ __forceinline__ void xcd_barrier_complete(unsigned* bar, unsigned x, unsigned& nloc, unsigned& nx) {
    const unsigned G = gridDim.x * gridDim.y * gridDim.z;
    unsigned sum, cnt, mine, sp = 0u;
    for (;;) {
        sum = 0u; cnt = 0u; mine = 0u;
#pragma unroll
        for (unsigned j = 0; j < 16; ++j) { const unsigned c = xb_ld(&bar[XB_XCNT(j)]); sum += c; cnt += (c > 0u) ? 1u : 0u; mine = (j == x) ? c : mine; }
        if (sum == G) break;
        __builtin_amdgcn_s_sleep(1);
        if ((++sp & 255u) == 0u) { if (xb_ld(&bar[XB_TMO])) break; if (sp > XB_SPIN_CAP) { atomicAdd(&bar[XB_TMO], 1u); break; } }
    }
    nloc = mine > 0u ? mine : 1u; nx = cnt > 0u ? cnt : 1u;
}

__device__ __forceinline__ void xcd_barrier(const XcdBarrier& b) {
    asm volatile("s_waitcnt vmcnt(0)" ::: "memory");
    __syncthreads();
    if (threadIdx.x == 0) {
        unsigned* bar = b.bar;
        __builtin_amdgcn_s_waitcnt(0);
        unsigned nloc = b.st[0], nx = b.st[1];
        if (nloc == 0u) { xcd_barrier_complete(bar, b.x, nloc, nx); b.st[0] = nloc; b.st[1] = nx; }
        const unsigned old = xb_add(&bar[XB_XSUB(b.x)], 1u);
        const unsigned gen = old / nloc;
        if (old + 1u == (gen + 1u) * nloc) {
            __builtin_amdgcn_fence(__ATOMIC_RELEASE, "agent");
            asm volatile("s_waitcnt vmcnt(0)" ::: "memory");
            const unsigned og = xb_add(&bar[XB_TOP], 1u);
            const unsigned tg = og / nx;
            if (og + 1u == (tg + 1u) * nx) xb_add(&bar[XB_TOPGEN], 1u);
            else XB_SPIN(xb_ld(&bar[XB_TOPGEN]) == tg, bar);
            __builtin_amdgcn_fence(__ATOMIC_ACQUIRE, "agent");
            xb_add(&bar[XB_XGEN(b.x)], 1u);
            asm volatile("s_waitcnt vmcnt(0)" ::: "memory");
        } else {
            XB_SPIN(xb_ld(&bar[XB_XGEN(b.x)]) == gen, bar);
            __builtin_amdgcn_fence(__ATOMIC_ACQUIRE, "agent");
            asm volatile("s_waitcnt vmcnt(0)" ::: "memory");
        }
    }
    __syncthreads();
}


struct P {
    const float *x, *meta, *w_in, *conv_w, *conv_b, *fw1, *fb1, *fw2, *fb2, *fw3, *ffreq, *fskip, *hy_norm, *lb_f, *lb_b, *hg_norm,
        *w_out, *norm_mix, *norm_ffn, *w_rg, *w_re, *w_gate, *w_up, *w_down, *norm_final;
    float* out;
    unsigned* bar;
    unsigned* cnt;
    bf16* A;
    bf16* Am;
    bf16* pT;
    bf16* pg;
    bf16* G;
    bf16* z2;
    bf16* o;
    bf16* h1;
    float* rstd;
    int* list;
    float* rsl;
    int* asg_e;
    int* asg_rank;
    float* asg_gate;
    bf16* hid;
    bf16* y;
    bf16 *W1t, *W2t, *Wgu, *Wd;
    bf16* Wr;
};

__device__ __forceinline__ void ph_norm1(const P& p) {
    int tid_ = threadIdx.x; asm volatile("" : "+v"(tid_));
    const int lane = tid_ & 63, wpb = blockDim.x >> 6;
    const int wave = blockIdx.x * wpb + (tid_ >> 6), nw = gridDim.x * wpb;
    float4 gn[4];
#pragma unroll
    for (int i = 0; i < 4; ++i) gn[i] = ((const float4*)p.norm_mix)[i * 64 + lane];
    constexpr int NR = NX + NMETA;
    for (int tok = wave; tok < NR; tok += 2 * nw) {
        const int tk[2] = {tok, tok + nw < NR ? tok + nw : tok};
        float4 v[2][4]; float ss[2];
#pragma unroll
        for (int q = 0; q < 2; ++q) {
            const float* src = tk[q] >= NX ? p.meta + (size_t)(tk[q] - NX) * D : p.x + (size_t)tk[q] * D;
#pragma unroll
            for (int i = 0; i < 4; ++i) v[q][i] = ((const float4*)src)[i * 64 + lane];
        }
#pragma unroll
        for (int q = 0; q < 2; ++q) { float s = 0.f;
#pragma unroll
            for (int i = 0; i < 4; ++i) s += v[q][i].x * v[q][i].x + v[q][i].y * v[q][i].y + v[q][i].z * v[q][i].z + v[q][i].w * v[q][i].w;
            ss[q] = wave_sum(s); }
#pragma unroll
        for (int q = 0; q < 2; ++q) {
            const float r = rsqrtf(ss[q] * (1.0f / D) + EPS);
            bf16* dst = tk[q] >= NX ? p.Am + (size_t)(tk[q] - NX) * D : p.A + (size_t)tk[q] * D;
#pragma unroll
            for (int i = 0; i < 4; ++i) {
                ushort4 o; o.x = f2bf(v[q][i].x * r * gn[i].x); o.y = f2bf(v[q][i].y * r * gn[i].y); o.z = f2bf(v[q][i].z * r * gn[i].z); o.w = f2bf(v[q][i].w * r * gn[i].w);
                ((ushort4*)dst)[i * 64 + lane] = o;
            }
        }
    }
}

typedef short bf16x8 __attribute__((ext_vector_type(8)));
typedef float f32x4 __attribute__((ext_vector_type(4)));
typedef unsigned u32x4 __attribute__((ext_vector_type(4)));
typedef unsigned u32x2 __attribute__((ext_vector_type(2)));
constexpr int BM = 256, BK = 64, HALF = 128, HTB = HALF * BK * 2, STAGE_BYTES = 8 * HTB;
__device__ __forceinline__ int lds_byte(int r, int c) { const int st = (r >> 4) * 2 + (c >> 5), rr = r & 15, cc = c & 31, ob = rr * 64 + cc * 2; return st * 1024 + (ob ^ (((ob >> 9) & 1) << 5)); }
__device__ __forceinline__ void stage_rc(int b, int& R, int& C) { const int st = b / 1024, sb = b % 1024, swz = sb ^ (((sb >> 9) & 1) << 5); R = (st >> 1) * 16 + swz / 64; C = (st & 1) * 32 + (swz % 64) / 2; }
__device__ __forceinline__ unsigned cvt_pk_bf16(float lo, float hi) { unsigned r; asm volatile("v_cvt_pk_bf16_f32 %0, %1, %2" : "=v"(r) : "v"(lo), "v"(hi)); return r; }

__device__ __forceinline__ float4 ld_bf4(const bf16* p) { const ushort4 u = *(const ushort4*)p; return make_float4(bf2f(u.x), bf2f(u.y), bf2f(u.z), bf2f(u.w)); }
__device__ __forceinline__ size_t blk16(int r, int c, int ncb) { return ((size_t)(r >> 4) * ncb + (c >> 4)) * 256 + (r & 15) * 16 + (c & 15); }
struct Unit { int pm, pn, e, r0; };
struct StaticOrder {
    int nM, nN, nwg, G, c;
    __device__ void init(int nM_, int nN_, int G_, int c_) { nM = nM_; nN = nN_; nwg = nM * nN; G = G_; c = c_; }
    __device__ bool next(int i, Unit& u) const {
        const long Lx = (long)i * G + c; if (Lx >= nwg) return false;
        int wgid = (int)Lx; { const int q = nwg / 8, r = nwg % 8, xcd = wgid % 8, off = wgid / 8; wgid = (xcd < r ? xcd * (q + 1) : r * (q + 1) + (xcd - r) * q) + off; }
        const int nig = 8 * nN, gid = wgid / nig, fm = gid * 8, gsz = (nM - fm) < 8 ? (nM - fm) : 8;
        u.pm = fm + ((wgid % nig) % gsz); u.pn = (wgid % nig) / gsz; u.e = 0; u.r0 = 0; return true;
    }
};

template <class GC, class Sched, class Epi>
__device__ __forceinline__ void gemm_phase(LAS unsigned char* lds, const GC& g, const Sched& S, const Epi& E) {
    int tid_ = threadIdx.x; asm volatile("" : "+v"(tid_));
    const int tid = tid_, wid = __builtin_amdgcn_readfirstlane(tid >> 6), lane = tid & 63, wr = wid >> 2, wc = wid & 3, fr = lane & 15, fq = lane >> 4;
    const int K = g.K, nt = K / BK;
    int Rr[2], Cc[2]; unsigned voffB[2];
#pragma unroll
    for (int i = 0; i < 2; ++i) { stage_rc(tid * 16 + i * 8192, Rr[i], Cc[i]); voffB[i] = (unsigned)(Rr[i] * K + Cc[i]) * 2u; }
    const size_t kstep = (size_t)(BK * 2), kstepA = (size_t)g.kstepA;
    const size_t hstepB = (size_t)HALF * K * 2;
    const unsigned ldsw = (unsigned)wid * 1024u;
    const int aoff = lds_byte(wr * 64 + fr, fq * 8), boff = lds_byte(wc * 32 + fr, fq * 8);
#define PG8_SA(b, h) (((b) * 2 + (h)) * HTB)
#define PG8_SB(b, h) ((4 + (b) * 2 + (h)) * HTB)
#define PG8_STAGE(bufoff, gbase, voff) do { _Pragma("unroll") for (int _i = 0; _i < 2; ++_i) \
        __builtin_amdgcn_global_load_lds((const unsigned*)((const char*)(gbase) + (voff)[_i]), (LAS unsigned*)(lds + (bufoff) + ldsw + _i * 8192), 16, 0, 0); } while (0)
#define PG8_LDA(dst, b, h) do { _Pragma("unroll") for (int m = 0; m < 4; ++m) _Pragma("unroll") for (int k = 0; k < 2; ++k) dst[m][k] = *(const LAS bf16x8*)(lds + PG8_SA(b, h) + aoff + m * 2048 + k * 1024); } while (0)
#define PG8_LDB(dst, b, h) do { _Pragma("unroll") for (int n = 0; n < 2; ++n) _Pragma("unroll") for (int k = 0; k < 2; ++k) dst[n][k] = *(const LAS bf16x8*)(lds + PG8_SB(b, h) + boff + n * 2048 + k * 1024); } while (0)
#define PG8_MMA(ai, bj, At, Bt) do { __builtin_amdgcn_s_setprio(1); _Pragma("unroll") for (int m = 0; m < 4; ++m) _Pragma("unroll") for (int n = 0; n < 2; ++n) _Pragma("unroll") for (int k = 0; k < 2; ++k) \
        acc[ai][bj][m][n] = __builtin_amdgcn_mfma_f32_16x16x32_bf16(Bt[n][k], At[m][k], acc[ai][bj][m][n], 0, 0, 0); __builtin_amdgcn_s_setprio(0); } while (0)
#define PG8_WAIT_V(n) asm volatile("s_waitcnt vmcnt(" #n ")" ::: "memory")
#define PG8_WAIT_L(n) asm volatile("s_waitcnt lgkmcnt(" #n ")" ::: "memory")
#define PG8_BAR __builtin_amdgcn_s_barrier()
#define PG8_SCHED __builtin_amdgcn_sched_barrier(0)
    Unit cur, nxt; int ui = 0;
    if (!S.next(0, cur)) return;
    f32x4 acc[2][2][4][2];
#pragma unroll
    for (int a = 0; a < 2; ++a)
#pragma unroll
        for (int b = 0; b < 2; ++b)
#pragma unroll
            for (int m = 0; m < 4; ++m)
#pragma unroll
                for (int n = 0; n < 2; ++n) acc[a][b][m][n] = (f32x4){0.f, 0.f, 0.f, 0.f};
    bf16x8 At[4][2], B0[2][2], B1[2][2];
    unsigned ca[2][2], na[2][2];
#pragma unroll
    for (int h = 0; h < 2; ++h)
#pragma unroll
        for (int i = 0; i < 2; ++i) ca[h][i] = g.aoff(cur, h * HALF + Rr[i], Cc[i]);
    const char* const A0 = g.A;
    const char* cB = g.bptr(cur);
    PG8_STAGE(PG8_SB(0, 0), cB, voffB); PG8_STAGE(PG8_SA(0, 0), A0, ca[0]); PG8_STAGE(PG8_SB(0, 1), cB + hstepB, voffB); PG8_STAGE(PG8_SA(0, 1), A0, ca[1]);
    if (wr == 1) PG8_BAR;
    PG8_WAIT_V(4); PG8_BAR;
    PG8_STAGE(PG8_SB(1, 0), cB + kstep, voffB); PG8_STAGE(PG8_SA(1, 0), A0 + kstepA, ca[0]); PG8_STAGE(PG8_SB(1, 1), cB + hstepB + kstep, voffB);
    PG8_WAIT_V(6); PG8_BAR;
    for (;;) {
        const bool has_next = S.next(ui + 1, nxt);
        const char* nB = cB;
#pragma unroll
        for (int h = 0; h < 2; ++h)
#pragma unroll
            for (int i = 0; i < 2; ++i) na[h][i] = ca[h][i];
        if (has_next) {
            nB = g.bptr(nxt);
#pragma unroll
            for (int h = 0; h < 2; ++h)
#pragma unroll
                for (int i = 0; i < 2; ++i) na[h][i] = g.aoff(nxt, h * HALF + Rr[i], Cc[i]);
        }
        for (int t = 0; t < nt; t += 2) {
            const bool last = (t == nt - 2);
            const char* a1 = A0 + (size_t)(t + 1) * kstepA;
            const char* a2 = last ? A0 : A0 + (size_t)(t + 2) * kstepA; const char* b2 = last ? nB : cB + (size_t)(t + 2) * kstep;
            const char* a3 = a2 + kstepA; const char* b3 = b2 + kstep;
            unsigned s0[2], s1[2];
            s0[0] = last ? na[0][0] : ca[0][0]; s0[1] = last ? na[0][1] : ca[0][1]; s1[0] = last ? na[1][0] : ca[1][0]; s1[1] = last ? na[1][1] : ca[1][1];
            PG8_LDB(B0, 0, 0); PG8_SCHED; PG8_LDA(At, 0, 0); PG8_STAGE(PG8_SA(1, 1), a1, ca[1]);
            PG8_WAIT_L(8); PG8_BAR; PG8_WAIT_L(0); PG8_MMA(0, 0, At, B0); PG8_BAR; PG8_SCHED;
            PG8_LDB(B1, 0, 1); PG8_STAGE(PG8_SB(0, 0), b2, voffB);
            PG8_BAR; PG8_WAIT_L(0); PG8_MMA(0, 1, At, B1); PG8_BAR;
            PG8_LDA(At, 0, 1); PG8_STAGE(PG8_SA(0, 0), a2, s0);
            PG8_BAR; PG8_WAIT_L(0); PG8_MMA(1, 0, At, B0); PG8_BAR; PG8_SCHED;
            PG8_STAGE(PG8_SB(0, 1), b2 + hstepB, voffB);
            PG8_WAIT_V(6); PG8_BAR; PG8_MMA(1, 1, At, B1); PG8_BAR;
            PG8_LDB(B0, 1, 0); PG8_SCHED; PG8_LDA(At, 1, 0); PG8_STAGE(PG8_SA(0, 1), a2, s1);
            PG8_WAIT_L(8); PG8_BAR; PG8_WAIT_L(0); PG8_MMA(0, 0, At, B0); PG8_BAR; PG8_SCHED;
            PG8_LDB(B1, 1, 1); PG8_STAGE(PG8_SB(1, 0), b3, voffB);
            PG8_BAR; PG8_WAIT_L(0); PG8_MMA(0, 1, At, B1); PG8_BAR;
            PG8_LDA(At, 1, 1); PG8_STAGE(PG8_SA(1, 0), a3, s0);
            PG8_BAR; PG8_WAIT_L(0); PG8_MMA(1, 0, At, B0); PG8_BAR; PG8_SCHED;
            PG8_STAGE(PG8_SB(1, 1), b3 + hstepB, voffB);
            PG8_WAIT_V(6); PG8_BAR; PG8_MMA(1, 1, At, B1); PG8_BAR;
        }
        E(acc, cur, wr, wc, fr, fq);
        if (!has_next) break;
#pragma unroll
        for (int a = 0; a < 2; ++a)
#pragma unroll
            for (int b = 0; b < 2; ++b)
#pragma unroll
                for (int m = 0; m < 4; ++m)
#pragma unroll
                    for (int n = 0; n < 2; ++n) acc[a][b][m][n] = (f32x4){0.f, 0.f, 0.f, 0.f};
        cur = nxt; cB = nB; ++ui;
#pragma unroll
        for (int h = 0; h < 2; ++h)
#pragma unroll
            for (int i = 0; i < 2; ++i) ca[h][i] = na[h][i];
    }
    PG8_WAIT_V(0);
    if (wr == 0) PG8_BAR;
    PG8_BAR;
#undef PG8_SA
#undef PG8_SB
#undef PG8_STAGE
#undef PG8_LDA
#undef PG8_LDB
#undef PG8_MMA
#undef PG8_WAIT_V
#undef PG8_WAIT_L
#undef PG8_BAR
#undef PG8_SCHED
}

template <class RM>
__device__ __forceinline__ void tconv_tile(const float* src, int ldn, int k0, int n0, bf16* dst, int ldd, RM rm, float* tile, const float* kscale = nullptr) {
    const int tid = threadIdx.x;
    __syncthreads();
    for (int idx = tid; idx < 1024; idx += blockDim.x) {
        const int kk = idx >> 4, nq = (idx & 15) * 4; float4 v = *(const float4*)(src + (size_t)(k0 + kk) * ldn + n0 + nq);
        if (kscale) { const float s = kscale[k0 + kk]; v.x *= s; v.y *= s; v.z *= s; v.w *= s; }
        float* tp = tile + kk * 65 + nq; tp[0] = v.x; tp[1] = v.y; tp[2] = v.z; tp[3] = v.w;
    }
    __syncthreads();
    { const int n = tid >> 3, kq = (tid & 7) * 8; const float* tp = tile + kq * 65 + n;
      uint4 o; o.x = cvt_pk_bf16(tp[0], tp[65]); o.y = cvt_pk_bf16(tp[130], tp[195]); o.z = cvt_pk_bf16(tp[260], tp[325]); o.w = cvt_pk_bf16(tp[390], tp[455]);
      *(uint4*)(dst + (size_t)rm(n0 + n) * ldd + k0 + kq) = o; }
}
struct CvDesc { const float* src; bf16* dst; int ldn, ldd, scale, k0; };
template <int MODE>
__device__ __forceinline__ CvDesc cv_decode(const P& p, int u) {
    CvDesc d;
    if (MODE == 1) {
        if (u < 512) { const int kt = u & 15, nt = u >> 4; d.src = p.w_in + (size_t)(kt * 64) * NPROJ + nt * 128; d.ldn = NPROJ; d.dst = p.W1t + (size_t)(nt * 128) * D + kt * 64; }
        else { const int q = u - 512, kt = q & 15, nt = q >> 4; d.src = p.w_out + (size_t)(kt * 64) * D + nt * 128; d.ldn = D; d.dst = p.W2t + (size_t)(nt * 128) * D + kt * 64; }
        d.ldd = D; d.scale = 0; d.k0 = 0; return d;
    }
    if (MODE == 0) { const int e = u >> 7, v = u & 127, w = v >> 6, q = v & 63, kt = q & 15, nt = q >> 4;
        d.src = (w ? p.w_up : p.w_gate) + (size_t)e * D * DE + (size_t)(kt * 64) * DE + nt * 128; d.ldn = DE; d.k0 = kt * 64; d.scale = 1;
        d.dst = p.Wgu + ((size_t)e * 1024 + nt * 256 + w * 128) * D + kt * 64; d.ldd = D; }
    else { const int e = u >> 6, q = u & 63, kt = q & 7, nt = q >> 3;
        d.src = p.w_down + (size_t)e * DE * D + (size_t)(kt * 64) * D + nt * 128; d.ldn = D; d.k0 = kt * 64; d.scale = 0;
        d.dst = p.Wd + ((size_t)e * 1024 + nt * 128) * DE + kt * 64; d.ldd = DE; }
    return d;
}
template <int MODE>
__device__ __forceinline__ void ph_conv(const P& p, float* tile, int it0, int it1) {
    int tid_ = threadIdx.x; asm volatile("" : "+v"(tid_));
    const int tid = tid_, total = MODE == 1 ? 640 : (MODE == 0 ? NE * 128 : NE * 64);
    float4 cur[4], nxt[4];
    int u = blockIdx.x + it0 * gridDim.x;
    const int uend = (long)blockIdx.x + (long)it1 * gridDim.x < total ? blockIdx.x + it1 * gridDim.x : total;
    CvDesc dc{};
    if (u < uend) { dc = cv_decode<MODE>(p, u);
#pragma unroll
        for (int q = 0; q < 4; ++q) { const int idx = tid + 512 * q, kk = idx >> 5, nq = (idx & 31) * 4; cur[q] = *(const float4*)(dc.src + (size_t)kk * dc.ldn + nq); } }
    for (; u < uend; u += gridDim.x) {
        const int un = u + gridDim.x; CvDesc dn = dc;
        if (un < uend) { dn = cv_decode<MODE>(p, un);
#pragma unroll
            for (int q = 0; q < 4; ++q) { const int idx = tid + 512 * q, kk = idx >> 5, nq = (idx & 31) * 4; nxt[q] = *(const float4*)(dn.src + (size_t)kk * dn.ldn + nq); } }
        __syncthreads();
#pragma unroll
        for (int q = 0; q < 4; ++q) { const int idx = tid + 512 * q, kk = idx >> 5, nq = (idx & 31) * 4; const float s = dc.scale ? p.norm_ffn[dc.k0 + kk] : 1.0f;
            float* tp = tile + kk * 129 + nq; tp[0] = cur[q].x * s; tp[1] = cur[q].y * s; tp[2] = cur[q].z * s; tp[3] = cur[q].w * s; }
        __syncthreads();
        { const int n = tid >> 2, kq = (tid & 3) * 16; const float* tp = tile + kq * 129 + n;
          u32x4 o0, o1;
          o0.x = cvt_pk_bf16(tp[0], tp[129]); o0.y = cvt_pk_bf16(tp[2 * 129], tp[3 * 129]); o0.z = cvt_pk_bf16(tp[4 * 129], tp[5 * 129]); o0.w = cvt_pk_bf16(tp[6 * 129], tp[7 * 129]);
          o1.x = cvt_pk_bf16(tp[8 * 129], tp[9 * 129]); o1.y = cvt_pk_bf16(tp[10 * 129], tp[11 * 129]); o1.z = cvt_pk_bf16(tp[12 * 129], tp[13 * 129]); o1.w = cvt_pk_bf16(tp[14 * 129], tp[15 * 129]);
          bf16* dp = dc.dst + (size_t)n * dc.ldd + kq; *(u32x4*)dp = o0; *(u32x4*)(dp + 8) = o1; }
        dc = dn;
#pragma unroll
        for (int q = 0; q < 4; ++q) cur[q] = nxt[q];
    }
    __syncthreads();
}

template <int MODE>
__device__ __forceinline__ void conv_tiles(const P& p, float* tile, int u0, int n) {
    int tid_ = threadIdx.x; asm volatile("" : "+v"(tid_));
    const int tid = tid_, total = MODE == 1 ? 640 : (MODE == 0 ? NE * 128 : NE * 64);
    for (int u = u0; u < u0 + n && u < total; ++u) {
        const CvDesc dc = cv_decode<MODE>(p, u);
        float4 cur[4];
#pragma unroll
        for (int q = 0; q < 4; ++q) { const int idx = tid + 512 * q, kk = idx >> 5, nq = (idx & 31) * 4; cur[q] = *(const float4*)(dc.src + (size_t)kk * dc.ldn + nq); }
        __syncthreads();
#pragma unroll
        for (int q = 0; q < 4; ++q) { const int idx = tid + 512 * q, kk = idx >> 5, nq = (idx & 31) * 4; const float s = dc.scale ? p.norm_ffn[dc.k0 + kk] : 1.0f;
            float* tp = tile + kk * 129 + nq; tp[0] = cur[q].x * s; tp[1] = cur[q].y * s; tp[2] = cur[q].z * s; tp[3] = cur[q].w * s; }
        __syncthreads();
        { const int n_ = tid >> 2, kq = (tid & 3) * 16; const float* tp = tile + kq * 129 + n_;
          u32x4 o0, o1;
          o0.x = cvt_pk_bf16(tp[0], tp[129]); o0.y = cvt_pk_bf16(tp[2 * 129], tp[3 * 129]); o0.z = cvt_pk_bf16(tp[4 * 129], tp[5 * 129]); o0.w = cvt_pk_bf16(tp[6 * 129], tp[7 * 129]);
          o1.x = cvt_pk_bf16(tp[8 * 129], tp[9 * 129]); o1.y = cvt_pk_bf16(tp[10 * 129], tp[11 * 129]); o1.z = cvt_pk_bf16(tp[12 * 129], tp[13 * 129]); o1.w = cvt_pk_bf16(tp[14 * 129], tp[15 * 129]);
          bf16* dp = dc.dst + (size_t)n_ * dc.ldd + kq; *(u32x4*)dp = o0; *(u32x4*)(dp + 8) = o1; }
    }
}

struct GIn { const char* A; int kstepA, K; const char* Bt;
    __device__ __forceinline__ unsigned aoff(const Unit& u, int r, int C) const { const int row = u.pm * BM + (u.pn < NHY / BM ? (r & ~63) + 4 * (r & 15) + ((r >> 4) & 3) : r); return (unsigned)row * (D * 2) + (unsigned)(C * 2); }
    __device__ __forceinline__ const char* bptr(const Unit& u) const { return Bt + (size_t)u.pn * BM * K * 2; } };
struct EpiIn { static constexpr int KIND = 1; bf16* pT; bf16* pg;
    __device__ __forceinline__ void operator()(const f32x4 (&acc)[2][2][4][2], const Unit& u, int wr, int wc, int fr, int fq) const {
        if (u.pn < NHY / BM) {
#pragma unroll
            for (int ai = 0; ai < 2; ++ai) { const int xr = u.pm * BM + ai * HALF + wr * 64 + 4 * fr, b = xr / SEQ, t = NMETA + xr % SEQ;
#pragma unroll
                for (int bj = 0; bj < 2; ++bj)
#pragma unroll
                    for (int n = 0; n < 2; ++n)
#pragma unroll
                        for (int j = 0; j < 4; ++j) { const int col = u.pn * BM + bj * HALF + wc * 32 + n * 16 + 4 * fq + j;
                            uint2 o; o.x = cvt_pk_bf16(acc[ai][bj][0][n][j], acc[ai][bj][1][n][j]); o.y = cvt_pk_bf16(acc[ai][bj][2][n][j], acc[ai][bj][3][n][j]);
                            *(uint2*)(pT + ((size_t)col * BATCH + b) * LP + t) = o; } }
        } else {
            const int act = 0;
#pragma unroll
            for (int ai = 0; ai < 2; ++ai)
#pragma unroll
                for (int m = 0; m < 4; ++m) { const int xr = u.pm * BM + ai * HALF + wr * 64 + m * 16 + fr; const int tok = (xr / SEQ) * L + NMETA + xr % SEQ;
#pragma unroll
                    for (int bj = 0; bj < 2; ++bj)
#pragma unroll
                        for (int n = 0; n < 2; ++n) { f32x4 v = acc[ai][bj][m][n];
                            if (act) {
#pragma unroll
                                for (int j = 0; j < 4; ++j) { const float sgm = __builtin_amdgcn_rcpf(1.0f + __builtin_amdgcn_exp2f(-1.44269504f * v[j])); v[j] = act == 1 ? v[j] * sgm : sgm; } }
                            uint2 o; o.x = cvt_pk_bf16(v[0], v[1]); o.y = cvt_pk_bf16(v[2], v[3]);
                            *(uint2*)(pg + blk16(tok, (u.pn * BM - NHY) + bj * HALF + wc * 32 + n * 16 + 4 * fq, NHG / 16)) = o; } }
        }
    } };
__device__ __forceinline__ void ph_inproj_meta(const P& p, LAS unsigned char* lds) {
    int tid_ = threadIdx.x; asm volatile("" : "+v"(tid_));
    const int tid = tid_, w = __builtin_amdgcn_readfirstlane(tid >> 6), lane = tid & 63, i = lane & 15, g = lane >> 4;
    LAS float* part = (LAS float*)lds;
    for (int ct = blockIdx.x; ct < NPROJ / 16; ct += gridDim.x) {
        __syncthreads();
        f32x4 acc = (f32x4){0.f, 0.f, 0.f, 0.f};
#pragma unroll
        for (int kk = 0; kk < 4; ++kk) {
            const int k = 128 * w + 32 * kk + 8 * g;
            const bf16x8 a = *(const bf16x8*)(p.W1t + (size_t)(16 * ct + i) * D + k), bb = *(const bf16x8*)(p.Am + (size_t)i * D + k);
            acc = __builtin_amdgcn_mfma_f32_16x16x32_bf16(a, bb, acc, 0, 0, 0);
        }
#pragma unroll
        for (int r = 0; r < 4; ++r) part[(w * 16 + 4 * g + r) * 17 + i] = acc[r];
        __syncthreads();
        if (tid < 256) {
            const int cl = tid >> 4, t = tid & 15, col = 16 * ct + cl; float v = 0.f;
#pragma unroll
            for (int ww = 0; ww < 8; ++ww) v += part[(ww * 16 + cl) * 17 + t];
            if (col < NHY) { const bf16 o = f2bf(v);
#pragma unroll
                for (int b = 0; b < BATCH; ++b) p.pT[((size_t)col * BATCH + b) * LP + t] = o; }
            else { const int act = 0;
                if (act) { const float sgm = __builtin_amdgcn_rcpf(1.0f + __builtin_amdgcn_exp2f(-1.44269504f * v)); v = act == 1 ? v * sgm : sgm; }
                const bf16 o = f2bf(v);
#pragma unroll
                for (int b = 0; b < BATCH; ++b) p.pg[blk16(b * L + t, col - NHY, NHG / 16)] = o; }
        }
    }
    __syncthreads();
}
__device__ __forceinline__ void ph_inproj(const P& p, LAS unsigned char* lds) {
    GIn g{(const char*)p.A, BK * 2, D, (const char*)p.W1t}; StaticOrder S; S.init(NX / BM, NPROJ / BM, gridDim.x, blockIdx.x); EpiIn E{p.pT, p.pg};
    gemm_phase(lds, g, S, E);
    ph_inproj_meta(p, lds);
}
struct GOut { const char* A; int kstepA, K; const char* Bt;
    __device__ __forceinline__ unsigned aoff(const Unit& u, int r, int C) const { return (unsigned)(u.pm * BM + r) * (D * 2) + (unsigned)(C * 2); }
    __device__ __forceinline__ const char* bptr(const Unit& u) const { return Bt + (size_t)u.pn * BM * K * 2; } };
struct EpiOut { static constexpr int KIND = 2; const float* x; bf16* h1;
    __device__ __forceinline__ void operator()(const f32x4 (&acc)[2][2][4][2], const Unit& u, int wr, int wc, int fr, int fq) const {
#pragma unroll
        for (int ai = 0; ai < 2; ++ai)
#pragma unroll
            for (int m = 0; m < 4; ++m) { const int row = u.pm * BM + ai * HALF + wr * 64 + m * 16 + fr, col0 = u.pn * BM + wc * 32 + 4 * fq;
#pragma unroll
                for (int bj = 0; bj < 2; ++bj)
#pragma unroll
                    for (int n = 0; n < 2; ++n) { const int col = col0 + bj * HALF + n * 16; const f32x4 v = *(const f32x4*)(x + (size_t)row * D + col) + acc[ai][bj][m][n];
                        u32x2 o; o.x = cvt_pk_bf16(v[0], v[1]); o.y = cvt_pk_bf16(v[2], v[3]); *(u32x2*)(h1 + (size_t)row * D + col) = o; } }
    } };
__device__ __forceinline__ void ph_outproj(const P& p, LAS unsigned char* lds) {
    GOut g{(const char*)p.A, BK * 2, D, (const char*)p.W2t}; StaticOrder S; S.init(NX / BM, D / BM, gridDim.x, blockIdx.x); EpiOut E{p.x, p.h1};
    gemm_phase(lds, g, S, E);
}

constexpr int ZS = 2088, ZSB = ZS * 2;
constexpr int HY_ZB = 0, HY_Z1 = 16 * ZSB, HY_G0 = 2 * 16 * ZSB, HY_G1 = HY_G0 + GL * 2, HY_END = HY_G1 + GL * 2;
typedef short bf16x8a __attribute__((ext_vector_type(8), aligned(4)));

__device__ __forceinline__ float bflo(unsigned u) { return __uint_as_float(u << 16); }
__device__ __forceinline__ float bfhi(unsigned u) { return __uint_as_float(u & 0xffff0000u); }

__device__ __forceinline__ void hy_load_conv(const P& p, int col, LAS unsigned char* dst) {
    const float w0 = p.conv_w[col], w1 = p.conv_w[NHY + col], w2 = p.conv_w[2 * NHY + col], bb = p.conv_b[col];
    u32x4 v[9]; unsigned short hm[9], hp[9];
#pragma unroll
    for (int it = 0; it < 9; ++it) {
        const int gi = threadIdx.x + 512 * it, b = gi / (ZS / 8), t0 = (gi % (ZS / 8)) * 8;
        v[it] = (u32x4){0u, 0u, 0u, 0u}; hm[it] = 0; hp[it] = 0;
        if (gi < 16 * (ZS / 8) && t0 < L) {
            const bf16* src = p.pT + ((size_t)col * BATCH + b) * LP + t0;
            v[it] = *(const u32x4*)src;
            if (t0 > 0) hm[it] = src[-1];
            if (t0 + 8 < L) hp[it] = src[8];
        }
    }
#pragma unroll
    for (int it = 0; it < 9; ++it) {
        const int gi = threadIdx.x + 512 * it, b = gi / (ZS / 8), t0 = (gi % (ZS / 8)) * 8;
        if (gi < 16 * (ZS / 8)) {
            u32x4 o = (u32x4){0u, 0u, 0u, 0u};
            if (t0 < L) {
                float f[10];
                f[0] = bf2f(hm[it]); f[9] = bf2f(hp[it]);
                f[1] = bflo(v[it].x); f[2] = bfhi(v[it].x); f[3] = bflo(v[it].y); f[4] = bfhi(v[it].y); f[5] = bflo(v[it].z); f[6] = bfhi(v[it].z); f[7] = bflo(v[it].w); f[8] = bfhi(v[it].w);
                float u[8];
#pragma unroll
                for (int j = 0; j < 8; ++j) u[j] = bb + w0 * f[j] + w1 * f[j + 1] + w2 * f[j + 2];
                o.x = cvt_pk_bf16(u[0], u[1]); o.y = cvt_pk_bf16(u[2], u[3]); o.z = cvt_pk_bf16(u[4], u[5]); o.w = cvt_pk_bf16(u[6], u[7]);
            }
            *(LAS u32x4*)(dst + b * ZSB + t0 * 2) = o;
        }
    }
}
__device__ __forceinline__ void hy_load_taps(const P& p, int order, int c, LAS unsigned char* lds) {
    const bf16* src = p.G + ((size_t)order * 512 + c) * GL;
    for (int k = threadIdx.x; k < GL / 8; k += blockDim.x) {
        const u32x4 v = *(const u32x4*)(src + k * 8);
        const unsigned nx = (k * 8 + 8 < GL) ? (unsigned)src[k * 8 + 8] : 0u;
        *(LAS u32x4*)(lds + HY_G0 + k * 16) = v;
        u32x4 s; s.x = (v.x >> 16) | (v.y << 16); s.y = (v.y >> 16) | (v.z << 16); s.z = (v.z >> 16) | (v.w << 16); s.w = (v.w >> 16) | (nx << 16);
        *(LAS u32x4*)(lds + HY_G1 + k * 16) = s;
    }
}
template <int STAGE>
__device__ __forceinline__ void hy_stage(const P& p, LAS unsigned char* lds, int c, float skip) {
    int tid_ = threadIdx.x; asm volatile("" : "+v"(tid_));
    const int tid = tid_, w = __builtin_amdgcn_readfirstlane(tid >> 6), lane = tid & 63, i = lane & 15, g = lane >> 4;
    const int it0 = w * 17;
    const LAS unsigned char* zsrc = lds + (STAGE == 0 ? HY_ZB : HY_Z1) + i * ZSB + g * 16;
    const LAS unsigned char* gl0 = ((i & 1) ? lds + HY_G0 + 2 * (8 * g - i + L - 1) : lds + HY_G1 + 2 * (8 * g - i + L - 2)) - 32 * it0;
    f32x4 acc[17];
#pragma unroll
    for (int a = 0; a < 17; ++a) acc[a] = (f32x4){0.f, 0.f, 0.f, 0.f};
    bf16x8 R[20];
#pragma unroll
    for (int a = 0; a < 17; ++a) R[a] = *(const LAS bf16x8a*)(gl0 - 32 * a);
    bf16x8 Zc = *(const LAS bf16x8*)zsrc, Zn = Zc;
    const bool full = (w != 7);
#define HY_STEP(u, js, PF) do { \
        if (PF) { R[(40 - 2 * ((u) + 1)) % 20] = *(const LAS bf16x8a*)(gl0 + 64 * ((js) + 1)); R[(41 - 2 * ((u) + 1)) % 20] = *(const LAS bf16x8a*)(gl0 + 64 * ((js) + 1) - 32); \
                  Zn = *(const LAS bf16x8*)(zsrc + 64 * ((js) + 1)); } \
        _Pragma("unroll") for (int a = 0; a < 10; ++a) acc[a] = __builtin_amdgcn_mfma_f32_16x16x32_bf16(R[(a + 40 - 2 * (u)) % 20], Zc, acc[a], 0, 0, 0); \
        if (full) { _Pragma("unroll") for (int a = 10; a < 17; ++a) acc[a] = __builtin_amdgcn_mfma_f32_16x16x32_bf16(R[(a + 40 - 2 * (u)) % 20], Zc, acc[a], 0, 0, 0); } \
        Zc = Zn; } while (0)
    for (int jb = 0; jb < 60; jb += 10) {
#pragma unroll
        for (int u = 0; u < 10; ++u) HY_STEP(u, jb + u, true);
    }
#pragma unroll
    for (int u = 0; u < 5; ++u) HY_STEP(u, 60 + u, u < 4);
#undef HY_STEP
#pragma unroll
    for (int a = 0; a < 17; ++a) {
        const int it = it0 + a;
        if (it < 129) {
            const int t = 16 * it + 4 * g, ad = i * ZSB + t * 2;
            const u32x2 zv = *(const LAS u32x2*)(lds + HY_ZB + ad), z1v = *(const LAS u32x2*)(lds + HY_Z1 + ad);
            if (STAGE == 0) {
                u32x2 o;
                o.x = cvt_pk_bf16(bflo(z1v.x) * (acc[a][0] + skip * bflo(zv.x)), bfhi(z1v.x) * (acc[a][1] + skip * bfhi(zv.x)));
                o.y = cvt_pk_bf16(bflo(z1v.y) * (acc[a][2] + skip * bflo(zv.y)), bfhi(z1v.y) * (acc[a][3] + skip * bfhi(zv.y)));
                *(LAS u32x2*)(lds + HY_Z1 + ad) = o;
            } else {
                u32x2 o;
                o.x = cvt_pk_bf16(bflo(zv.x) * (acc[a][0] + skip * bflo(z1v.x)), bfhi(zv.x) * (acc[a][1] + skip * bfhi(z1v.x)));
                o.y = cvt_pk_bf16(bflo(zv.y) * (acc[a][2] + skip * bflo(z1v.y)), bfhi(zv.y) * (acc[a][3] + skip * bfhi(z1v.y)));
                *(u32x2*)(p.z2 + ((size_t)c * BATCH + i) * LP + t) = o;
            }
        }
    }
}
__device__ __forceinline__ void hyena_channel(const P& p, LAS unsigned char* lds, int c) {
    {
        __syncthreads();
        hy_load_conv(p, c, lds + HY_ZB); hy_load_conv(p, DH + c, lds + HY_Z1); hy_load_taps(p, 0, c, lds);
        __syncthreads();
        hy_stage<0>(p, lds, c, p.fskip[c]);
        __syncthreads();
        hy_load_conv(p, 2 * DH + c, lds + HY_ZB); hy_load_taps(p, 1, c, lds);
        __syncthreads();
        hy_stage<1>(p, lds, c, p.fskip[DH + c]);
    }
}

constexpr int HG_RS = 272, HG_RS64 = 144;
constexpr int HG_QS = 0, HG_KS = HG_QS + 64 * HG_RS, HG_KDT = HG_KS + 64 * HG_RS, HG_VT = HG_KDT + 128 * HG_RS64, HG_SC = HG_VT + 128 * HG_RS64, HG_ST = HG_SC + 64 * HG_RS64,
              HG_DEC = HG_ST + 128 * HG_RS, HG_EBM = HG_DEC + 128 * 4, HG_END = HG_EBM + 128 * 4;
__device__ __forceinline__ float dpp_add_(float v, const int ctrl_sel) {
    int t;
    const int iv = __float_as_int(v);
    if (ctrl_sel == 0) t = __builtin_amdgcn_update_dpp(0, iv, 0x111, 0xf, 0xf, false);
    else if (ctrl_sel == 1) t = __builtin_amdgcn_update_dpp(0, iv, 0x112, 0xf, 0xf, false);
    else if (ctrl_sel == 2) t = __builtin_amdgcn_update_dpp(0, iv, 0x114, 0xf, 0xf, false);
    else if (ctrl_sel == 3) t = __builtin_amdgcn_update_dpp(0, iv, 0x118, 0xf, 0xf, false);
    else if (ctrl_sel == 4) t = __builtin_amdgcn_update_dpp(0, iv, 0x142, 0xa, 0xf, false);
    else t = __builtin_amdgcn_update_dpp(0, iv, 0x143, 0xc, 0xf, false);
    return v + __int_as_float(t);
}
__device__ __forceinline__ float wave_incl_scan(float v) { v = dpp_add_(v, 0); v = dpp_add_(v, 1); v = dpp_add_(v, 2); v = dpp_add_(v, 3); v = dpp_add_(v, 4); v = dpp_add_(v, 5); return v; }
__device__ __forceinline__ float dpp_mul_(float v, const int ctrl_sel) {
    int t; const int iv = __float_as_int(v), one = 0x3f800000;
    if (ctrl_sel == 0) t = __builtin_amdgcn_update_dpp(one, iv, 0x111, 0xf, 0xf, false);
    else if (ctrl_sel == 1) t = __builtin_amdgcn_update_dpp(one, iv, 0x112, 0xf, 0xf, false);
    else if (ctrl_sel == 2) t = __builtin_amdgcn_update_dpp(one, iv, 0x114, 0xf, 0xf, false);
    else if (ctrl_sel == 3) t = __builtin_amdgcn_update_dpp(one, iv, 0x118, 0xf, 0xf, false);
    else if (ctrl_sel == 4) t = __builtin_amdgcn_update_dpp(one, iv, 0x142, 0xa, 0xf, false);
    else t = __builtin_amdgcn_update_dpp(one, iv, 0x143, 0xc, 0xf, false);
    return v * __int_as_float(t);
}
__device__ __forceinline__ float wave_incl_prod(float v) { v = dpp_mul_(v, 0); v = dpp_mul_(v, 1); v = dpp_mul_(v, 2); v = dpp_mul_(v, 3); v = dpp_mul_(v, 4); v = dpp_mul_(v, 5); return v; }
__device__ __forceinline__ float rdlane(float v, int l) { return __int_as_float(__builtin_amdgcn_readlane(__float_as_int(v), l)); }

__device__ __forceinline__ void hgrn_unit(const P& p, LAS unsigned char* lds, int u) {
    int tid_ = threadIdx.x; asm volatile("" : "+v"(tid_));
    const int tid = tid_, w = __builtin_amdgcn_readfirstlane(tid >> 6), lane = tid & 63, i = lane & 15, g = lane >> 4;
    {
        const int dir = u & 1, h = (u >> 1) & 3, b = u >> 3;
        float lbv[16];
#pragma unroll
        for (int dd = 0; dd < 16; ++dd) { const float* lbp = dir ? p.lb_b : p.lb_f; const float a0 = lbp[h * 128 + 16 * w + dd], a1 = lbp[DG + h * 128 + 16 * w + dd], mx = fmaxf(a0, a1);
            const float e0 = __expf(a0 - mx), e1 = __expf(a1 - mx); lbv[dd] = e0 / (e0 + e1); }
        const int tokb = b * L;
        const int qoff = h * 128 + 16 * w, foff = (dir ? 1024 : 512) + h * 128 + 16 * w, voff = 1536 + h * 128 + 16 * w;
        bf16* po = p.o + ((size_t)dir * NTOK + (size_t)b * L) * DG + h * 128;
        f32x4 S[8];
#pragma unroll
        for (int vi = 0; vi < 8; ++vi) S[vi] = (f32x4){0.f, 0.f, 0.f, 0.f};
        __syncthreads();
        u32x4 rq0, rq1, rf0, rf1, rv0, rv1;
#define HG_TOK(m, j) (dir ? 64 * (m) + 15 - (j) : 64 * (m) - 48 + (j))
#define HG_LOADRAW(m) do { const int t_ = HG_TOK(m, lane); rq0 = rq1 = rf0 = rf1 = rv0 = rv1 = (u32x4){0u, 0u, 0u, 0u}; \
            if (t_ >= 0) { const bf16* r_ = p.pg + blk16(tokb + t_, 0, NHG / 16); rq0 = *(const u32x4*)(r_ + (qoff >> 4) * 256); rq1 = *(const u32x4*)(r_ + (qoff >> 4) * 256 + 8); \
                           rf0 = *(const u32x4*)(r_ + (foff >> 4) * 256); rf1 = *(const u32x4*)(r_ + (foff >> 4) * 256 + 8); rv0 = *(const u32x4*)(r_ + (voff >> 4) * 256); rv1 = *(const u32x4*)(r_ + (voff >> 4) * 256 + 8); } } while (0)
        HG_LOADRAW(dir ? 32 : 0);
        for (int n = 0; n < 33; ++n) {
            const int m = dir ? 32 - n : n;
            {
                const bool valid = HG_TOK(m, lane) >= 0;
                const unsigned qw[8] = {rq0.x, rq0.y, rq0.z, rq0.w, rq1.x, rq1.y, rq1.z, rq1.w}, fw[8] = {rf0.x, rf0.y, rf0.z, rf0.w, rf1.x, rf1.y, rf1.z, rf1.w};
                float qsv[16], ksv[16]; float decv = 0.f;
#pragma unroll
                for (int dd = 0; dd < 16; ++dd) {
                    const float qr = (dd & 1) ? bfhi(qw[dd >> 1]) : bflo(qw[dd >> 1]), fr_ = (dd & 1) ? bfhi(fw[dd >> 1]) : bflo(fw[dd >> 1]);
                    const float qq = qr * __builtin_amdgcn_rcpf(1.0f + __builtin_amdgcn_exp2f(-1.44269504f * qr)), fl = __builtin_amdgcn_rcpf(1.0f + __builtin_amdgcn_exp2f(-1.44269504f * fr_));
                    const float f = valid ? lbv[dd] + (1.0f - lbv[dd]) * fl : 1.0f, k = 1.0f - f;
                    const float Pj = wave_incl_prod(f), P63 = rdlane(Pj, 63);
                    qsv[dd] = qq * Pj; ksv[dd] = k * __builtin_amdgcn_rcpf(Pj);
                    *(LAS bf16*)(lds + HG_KDT + (16 * w + dd) * HG_RS64 + lane * 2) = f2bf(ksv[dd] * P63);
                    decv = (lane == dd) ? P63 : decv;
                }
                u32x4 o0, o1;
#define HG_PK(arr, dst) o0.x = cvt_pk_bf16(arr[0], arr[1]); o0.y = cvt_pk_bf16(arr[2], arr[3]); o0.z = cvt_pk_bf16(arr[4], arr[5]); o0.w = cvt_pk_bf16(arr[6], arr[7]); \
                        o1.x = cvt_pk_bf16(arr[8], arr[9]); o1.y = cvt_pk_bf16(arr[10], arr[11]); o1.z = cvt_pk_bf16(arr[12], arr[13]); o1.w = cvt_pk_bf16(arr[14], arr[15]); \
                        *(LAS u32x4*)(lds + (dst) + lane * HG_RS + 32 * w) = o0; *(LAS u32x4*)(lds + (dst) + lane * HG_RS + 32 * w + 16) = o1;
                HG_PK(qsv, HG_QS) HG_PK(ksv, HG_KS)
#undef HG_PK
                if (lane < 16) *(LAS float*)(lds + HG_DEC + (16 * w + lane) * 4) = decv;
                const unsigned vw[8] = {rv0.x, rv0.y, rv0.z, rv0.w, rv1.x, rv1.y, rv1.z, rv1.w};
#pragma unroll
                for (int e = 0; e < 16; ++e) *(LAS bf16*)(lds + HG_VT + (16 * w + e) * HG_RS64 + lane * 2) = (bf16)((e & 1) ? (vw[e >> 1] >> 16) : (vw[e >> 1] & 0xffffu));
            }
            if (n + 1 < 33) { const int mn = dir ? 31 - n : n + 1; HG_LOADRAW(mn); }
            __syncthreads();
            {
#pragma unroll
                for (int vi = 0; vi < 8; ++vi) { const f32x4 sv = S[vi]; u32x2 o; o.x = cvt_pk_bf16(sv[0], sv[1]); o.y = cvt_pk_bf16(sv[2], sv[3]); *(LAS u32x2*)(lds + HG_ST + (16 * vi + i) * HG_RS + (16 * w + 4 * g) * 2) = o; }
            }
            {
                const int si = w >> 1, tp = (w & 1) * 2;
                f32x4 sa[2] = {(f32x4){0.f, 0.f, 0.f, 0.f}, (f32x4){0.f, 0.f, 0.f, 0.f}};
#pragma unroll
                for (int kk = 0; kk < 4; ++kk) {
                    const bf16x8 A = *(const LAS bf16x8*)(lds + HG_KS + (16 * si + i) * HG_RS + (32 * kk + 8 * g) * 2);
#pragma unroll
                    for (int q = 0; q < 2; ++q) { const bf16x8 B = *(const LAS bf16x8*)(lds + HG_QS + (16 * (tp + q) + i) * HG_RS + (32 * kk + 8 * g) * 2); sa[q] = __builtin_amdgcn_mfma_f32_16x16x32_bf16(A, B, sa[q], 0, 0, 0); }
                }
#pragma unroll
                for (int q = 0; q < 2; ++q) {
                    const int t = 16 * (tp + q) + i, s0 = 16 * si + 4 * g;
                    u32x2 o; o.x = cvt_pk_bf16(s0 <= t ? sa[q][0] : 0.f, s0 + 1 <= t ? sa[q][1] : 0.f); o.y = cvt_pk_bf16(s0 + 2 <= t ? sa[q][2] : 0.f, s0 + 3 <= t ? sa[q][3] : 0.f);
                    *(LAS u32x2*)(lds + HG_SC + t * HG_RS64 + s0 * 2) = o;
                }
            }
            __syncthreads();
            {
                f32x4 oa[4];
#pragma unroll
                for (int q = 0; q < 4; ++q) oa[q] = (f32x4){0.f, 0.f, 0.f, 0.f};
#pragma unroll
                for (int kk = 0; kk < 2; ++kk) {
                    const bf16x8 A = *(const LAS bf16x8*)(lds + HG_VT + (16 * w + i) * HG_RS64 + (32 * kk + 8 * g) * 2);
#pragma unroll
                    for (int q = 0; q < 4; ++q) { const bf16x8 B = *(const LAS bf16x8*)(lds + HG_SC + (16 * q + i) * HG_RS64 + (32 * kk + 8 * g) * 2); oa[q] = __builtin_amdgcn_mfma_f32_16x16x32_bf16(A, B, oa[q], 0, 0, 0); }
                }
#pragma unroll
                for (int kk = 0; kk < 4; ++kk) {
                    const bf16x8 A = *(const LAS bf16x8*)(lds + HG_ST + (16 * w + i) * HG_RS + (32 * kk + 8 * g) * 2);
#pragma unroll
                    for (int q = 0; q < 4; ++q) { const bf16x8 B = *(const LAS bf16x8*)(lds + HG_QS + (16 * q + i) * HG_RS + (32 * kk + 8 * g) * 2); oa[q] = __builtin_amdgcn_mfma_f32_16x16x32_bf16(A, B, oa[q], 0, 0, 0); }
                }
#pragma unroll
                for (int q = 0; q < 4; ++q) {
                    const int t = HG_TOK(m, 16 * q + i);
                    if (t >= 0) { u32x2 o; o.x = cvt_pk_bf16(oa[q][0], oa[q][1]); o.y = cvt_pk_bf16(oa[q][2], oa[q][3]); *(u32x2*)(po + (size_t)t * DG + 16 * w + 4 * g) = o; }
                }
            }
            {
                const f32x4 dv = *(const LAS f32x4*)(lds + HG_DEC + (16 * w + 4 * g) * 4);
#pragma unroll
                for (int vi = 0; vi < 8; ++vi) S[vi] = S[vi] * dv;
#pragma unroll
                for (int kk = 0; kk < 2; ++kk) {
                    const bf16x8 A = *(const LAS bf16x8*)(lds + HG_KDT + (16 * w + i) * HG_RS64 + (32 * kk + 8 * g) * 2);
#pragma unroll
                    for (int vi = 0; vi < 8; ++vi) { const bf16x8 B = *(const LAS bf16x8*)(lds + HG_VT + (16 * vi + i) * HG_RS64 + (32 * kk + 8 * g) * 2); S[vi] = __builtin_amdgcn_mfma_f32_16x16x32_bf16(A, B, S[vi], 0, 0, 0); }
                }
            }
            __syncthreads();
        }
#undef HG_TOK
#undef HG_LOADRAW
    }
}
__device__ __forceinline__ void ph_mixers(const P& p, LAS unsigned char* lds, LAS int* ticket) {
    if ((blockIdx.x & 1) == 0) for (int u = blockIdx.x >> 1; u < BATCH * 8; u += (gridDim.x + 1) >> 1) hgrn_unit(p, lds, u);
    for (;;) {
        __syncthreads();
        if (threadIdx.x == 0) *ticket = (int)atomicAdd(p.cnt + 64, 1u);
        __syncthreads();
        const int c = *ticket;
        if (c >= DH) {
            const int u0 = 4 * (int)gridDim.x + 4 * (c - DH); if (u0 >= NE * 64) break;
            conv_tiles<2>(p, (float*)(void*)lds, u0, 4); continue; }
        hyena_channel(p, lds, c);
    }
    __syncthreads();
}

__device__ __forceinline__ void ph_filters(const P& p, float* sm) {
    float* z = sm; float* h1 = sm + 8 * 33; float* h2 = h1 + 8 * 64;
    int tid_ = threadIdx.x; asm volatile("" : "+v"(tid_));
    const int tid = tid_;
    for (int un = blockIdx.x; un < (L / 8) * 4; un += gridDim.x) {
        const int grp = un >> 2, nq = un & 3, j0 = grp * 8;
        __syncthreads();
        if (tid < 8 * 33) {
            const int lg = tid / 33, ft = tid % 33, j = j0 + lg; float v;
            if (ft == 0) v = (float)((double)j / (double)(L - 1));
            else { const int ib = (ft - 1) & 15; const double band = 1e-4 + (double)ib * ((double)(15) - 1e-4) / 15.0; double turns = (double)j * band / (double)L; turns -= floor(turns);
                   const float ang = 6.28318530717958647692f * (float)turns;
                   v = ft <= 16 ? cosf(ang) : -sinf(ang); }
            z[tid] = v;
        }
        __syncthreads();
        { const int lg = tid >> 6, hc = tid & 63; float a = p.fb1[hc];
#pragma unroll
          for (int q = 0; q < 33; ++q) a += z[lg * 33 + q] * p.fw1[q * 64 + hc];
          h1[tid] = sinf(p.ffreq[hc] * a); }
        __syncthreads();
        { const int lg = tid >> 6, hc = tid & 63; float a = p.fb2[hc];
#pragma unroll 16
          for (int q = 0; q < 64; ++q) a += h1[lg * 64 + q] * p.fw2[q * 64 + hc];
          h2[tid] = sinf(p.ffreq[hc] * a); }
        __syncthreads();
        {
            const int n = nq * 512 + tid;
            float acc[8];
#pragma unroll
            for (int lg = 0; lg < 8; ++lg) acc[lg] = 0.f;
#pragma unroll 4
            for (int q4 = 0; q4 < 16; ++q4) { const float w0 = p.fw3[(4 * q4) * 2048 + n], w1 = p.fw3[(4 * q4 + 1) * 2048 + n], w2 = p.fw3[(4 * q4 + 2) * 2048 + n], w3 = p.fw3[(4 * q4 + 3) * 2048 + n];
#pragma unroll
                for (int lg = 0; lg < 8; ++lg) { const float4 hv = *(const float4*)(h2 + lg * 64 + 4 * q4); acc[lg] += (hv.x * w0 + hv.y * w1) + (hv.z * w2 + hv.w * w3); } }
            const int dir = n >> 10, order = (n >> 9) & 1, c = n & 511;
            const float lo = -3.0701134573f  , hi = -15.3505672866f  ;
            const float delta = fabsf(lo + (hi - lo) * (float)c * (1.0f / 511.0f));
            bf16* gp = p.G + ((size_t)order * 512 + c) * GL;
            bf16 ov[8];
#pragma unroll
            for (int lg = 0; lg < 8; ++lg) ov[lg] = f2bf(acc[lg] * __expf(-z[lg * 33] * delta));
            if (dir == 0) {
                u32x4 o; o.x = (unsigned)ov[7] | ((unsigned)ov[6] << 16); o.y = (unsigned)ov[5] | ((unsigned)ov[4] << 16); o.z = (unsigned)ov[3] | ((unsigned)ov[2] << 16); o.w = (unsigned)ov[1] | ((unsigned)ov[0] << 16);
                *(u32x4*)(gp + (L - 8 - j0)) = o;
            } else {
#pragma unroll
                for (int lg = 0; lg < 8; ++lg) if (j0 + lg >= 1) gp[L - 1 + j0 + lg] = ov[lg];
            }
        }
    }
    for (int x = blockIdx.x * blockDim.x + tid; x < 1024 * (GL - (2 * L - 1)); x += gridDim.x * blockDim.x) {
        const int row = x / (GL - (2 * L - 1)), m = (2 * L - 1) + x % (GL - (2 * L - 1));
        p.G[(size_t)row * GL + m] = 0;
    }
    __syncthreads();
}

constexpr int BA_RS = 1040;
__device__ __forceinline__ void ph_buildA2(const P& p, LAS unsigned char* lds) {
    int tid_ = threadIdx.x; asm volatile("" : "+v"(tid_));
    const int tid = tid_, w = __builtin_amdgcn_readfirstlane(tid >> 6), lane = tid & 63;
    float hyn[8], hgn[8];
#pragma unroll
    for (int e = 0; e < 8; ++e) { hyn[e] = p.hy_norm[8 * lane + e]; hgn[e] = p.hg_norm[8 * lane + e]; }
    for (int u = blockIdx.x; u < BATCH * (SEQ / 64); u += gridDim.x) {
        const int b = u / (SEQ / 64), tt = u % (SEQ / 64), t0 = NMETA + 64 * tt;
        __syncthreads();
        {
            const bf16* src = p.z2 + ((size_t)tid * BATCH + b) * LP + t0;
            u32x4 v[8];
#pragma unroll
            for (int q = 0; q < 8; ++q) v[q] = *(const u32x4*)(src + 8 * q);
#pragma unroll
            for (int q = 0; q < 8; ++q) {
                const unsigned wv[4] = {v[q].x, v[q].y, v[q].z, v[q].w};
#pragma unroll
                for (int e = 0; e < 8; ++e) *(LAS bf16*)(lds + (8 * q + e) * BA_RS + tid * 2) = (bf16)((e & 1) ? (wv[e >> 1] >> 16) : (wv[e >> 1] & 0xffffu));
            }
        }
        __syncthreads();
#pragma unroll 2
        for (int jt = 8 * w; jt < 8 * w + 8; ++jt) {
            const size_t tok = (size_t)b * L + t0 + jt; bf16* dst = p.A + ((size_t)b * SEQ + 64 * tt + jt) * D;
            const u32x4 zv = *(const LAS u32x4*)(lds + jt * BA_RS + lane * 16);
            const u32x4 of = *(const u32x4*)(p.o + tok * DG + 8 * lane), ob = *(const u32x4*)(p.o + ((size_t)NTOK + tok) * DG + 8 * lane), gv = *(const u32x4*)(p.pg + blk16((int)tok, 2048 + 8 * lane, NHG / 16));
            float z[8] = {bflo(zv.x), bfhi(zv.x), bflo(zv.y), bfhi(zv.y), bflo(zv.z), bfhi(zv.z), bflo(zv.w), bfhi(zv.w)};
            float ss = 0.f;
#pragma unroll
            for (int e = 0; e < 8; ++e) ss += z[e] * z[e];
            ss = wave_sum(ss);
            const float r = rsqrtf(ss * (1.0f / DH) + EPS);
            u32x4 o; o.x = cvt_pk_bf16(z[0] * r * hyn[0], z[1] * r * hyn[1]); o.y = cvt_pk_bf16(z[2] * r * hyn[2], z[3] * r * hyn[3]);
            o.z = cvt_pk_bf16(z[4] * r * hyn[4], z[5] * r * hyn[5]); o.w = cvt_pk_bf16(z[6] * r * hyn[6], z[7] * r * hyn[7]);
            *(u32x4*)(dst + 8 * lane) = o;
            float ov[8] = {bflo(of.x) + bflo(ob.x), bfhi(of.x) + bfhi(ob.x), bflo(of.y) + bflo(ob.y), bfhi(of.y) + bfhi(ob.y), bflo(of.z) + bflo(ob.z), bfhi(of.z) + bfhi(ob.z), bflo(of.w) + bflo(ob.w), bfhi(of.w) + bfhi(ob.w)};
            const float gg[8] = {bflo(gv.x), bfhi(gv.x), bflo(gv.y), bfhi(gv.y), bflo(gv.z), bfhi(gv.z), bflo(gv.w), bfhi(gv.w)};
            float hs = 0.f;
#pragma unroll
            for (int e = 0; e < 8; ++e) hs += ov[e] * ov[e];
            hs += __shfl_xor(hs, 1); hs += __shfl_xor(hs, 2); hs += __shfl_xor(hs, 4); hs += __shfl_xor(hs, 8);
            const float hr = rsqrtf(hs * (1.0f / 128.0f) + EPS);
            float y[8];
#pragma unroll
            for (int e = 0; e < 8; ++e) y[e] = ov[e] * hr * hgn[e] * siluf_(gg[e]);
            u32x4 o2; o2.x = cvt_pk_bf16(y[0], y[1]); o2.y = cvt_pk_bf16(y[2], y[3]); o2.z = cvt_pk_bf16(y[4], y[5]); o2.w = cvt_pk_bf16(y[6], y[7]);
            *(u32x4*)(dst + DH + 8 * lane) = o2;
        }
    }
    __syncthreads();
}

__device__ __forceinline__ void ph_conv_router(const P& p) {
    for (int idx = blockIdx.x * blockDim.x + threadIdx.x; idx < 80 * 1024; idx += gridDim.x * blockDim.x) {
        const int n = idx >> 10, k = idx & 1023;
        const float wv = (n < 8 ? p.w_rg[k * 8 + n] : (n < 72 ? p.w_re[k * 64 + (n - 8)] : 0.f)) * p.norm_ffn[k];
        const bf16 hi = f2bf(wv); p.Wr[idx] = hi; p.Wr[80 * 1024 + idx] = f2bf(wv - bf2f(hi));
    }
}
template <bool DRY>
__device__ __forceinline__ void ph_router(const P& p, LAS unsigned char* lds) {
    int tid_ = threadIdx.x; asm volatile("" : "+v"(tid_));
    const int tid = tid_, w = __builtin_amdgcn_readfirstlane(tid >> 6), lane = tid & 63, i = lane & 15, g = lane >> 4;
    LAS float* lg = (LAS float*)lds + w * (16 * 81 + 16);
    LAS int* lcnt = (LAS int*)(lds + 8 * (16 * 81 + 16) * 4);
    constexpr int RT_WB = 8 * (16 * 81 + 16) * 4 + 1024;
    for (int tile = blockIdx.x; tile < NX / 128; tile += gridDim.x) {
        __syncthreads();
        if (tid < 64) lcnt[tid] = 0;
        __syncthreads();
        const int xr0 = tile * 128 + w * 16;
        const bf16* hrow = p.h1 + (size_t)(xr0 + i) * D + 8 * g;
        f32x4 acc[5];
#pragma unroll
        for (int nt = 0; nt < 5; ++nt) acc[nt] = (f32x4){0.f, 0.f, 0.f, 0.f};
        float ss = 0.f;
        for (int kc = 0; kc < 4; ++kc) {
            __syncthreads();
            for (int x = tid; x < 2 * 80 * 32; x += 512) { const int pl = x / 2560, rem = x % 2560, n = rem >> 5, c16 = rem & 31;
                *(LAS u32x4*)(lds + RT_WB + (pl * 80 + n) * 528 + c16 * 16) = *(const u32x4*)(p.Wr + (size_t)pl * 80 * 1024 + (size_t)n * 1024 + kc * 256 + c16 * 8); }
            __syncthreads();
#pragma unroll 4
            for (int k8 = 0; k8 < 8; ++k8) {
                const u32x4 hv = *(const u32x4*)(hrow + kc * 256 + 32 * k8);
                const float h0 = bflo(hv.x), h1_ = bfhi(hv.x), h2 = bflo(hv.y), h3 = bfhi(hv.y), h4 = bflo(hv.z), h5 = bfhi(hv.z), h6 = bflo(hv.w), h7 = bfhi(hv.w);
                ss += (h0 * h0 + h1_ * h1_) + (h2 * h2 + h3 * h3) + (h4 * h4 + h5 * h5) + (h6 * h6 + h7 * h7);
                const bf16x8 Ah = __builtin_bit_cast(bf16x8, hv);
#pragma unroll
                for (int nt = 0; nt < 5; ++nt) {
                    const bf16x8 bh = *(const LAS bf16x8*)(lds + RT_WB + (16 * nt + i) * 528 + (32 * k8 + 8 * g) * 2), bl = *(const LAS bf16x8*)(lds + RT_WB + (80 + 16 * nt + i) * 528 + (32 * k8 + 8 * g) * 2);
                    acc[nt] = __builtin_amdgcn_mfma_f32_16x16x32_bf16(Ah, bh, acc[nt], 0, 0, 0);
                    acc[nt] = __builtin_amdgcn_mfma_f32_16x16x32_bf16(Ah, bl, acc[nt], 0, 0, 0);
                }
            }
        }
        ss += __shfl_xor(ss, 16); ss += __shfl_xor(ss, 32);
        if (g == 0) lg[16 * 81 + i] = rsqrtf(ss * (1.0f / D) + EPS);
#pragma unroll
        for (int nt = 0; nt < 5; ++nt)
#pragma unroll
            for (int r = 0; r < 4; ++r) lg[(4 * g + r) * 81 + 16 * nt + i] = acc[nt][r];
        asm volatile("s_waitcnt lgkmcnt(0)" ::: "memory");
        int x0 = 0, x1 = 0, l0 = 0, l1 = 0; float gate0 = 0.f, gate1 = 0.f, rs = 0.f;
        if (lane < 16) {
            const LAS float* row = lg + lane * 81; rs = lg[16 * 81 + lane];
            float lgv[8];
#pragma unroll
            for (int q = 0; q < 8; ++q) lgv[q] = row[q] * rs;
            int gs = 0; float best = lgv[0];
#pragma unroll
            for (int q = 1; q < 8; ++q) if (lgv[q] > best) { best = lgv[q]; gs = q; }
            float den = 0.f;
#pragma unroll
            for (int q = 0; q < 8; ++q) den += __expf(lgv[q] - best);
            const float pgroup = 1.0f / den;
            float le[8];
#pragma unroll
            for (int q = 0; q < 8; ++q) le[q] = row[8 + gs * 8 + q] * rs;
            int e0 = 0; float b0 = le[0];
#pragma unroll
            for (int q = 1; q < 8; ++q) if (le[q] > b0) { b0 = le[q]; e0 = q; }
            int e1 = -1; float b1 = -3.0e38f;
#pragma unroll
            for (int q = 0; q < 8; ++q) if (q != e0 && le[q] > b1) { b1 = le[q]; e1 = q; }
            const float q1 = __expf(b1 - b0), inv = 1.0f / (1.0f + q1);
            x0 = gs * 8 + e0; x1 = gs * 8 + e1; gate0 = pgroup * inv; gate1 = pgroup * q1 * inv;
            if (!DRY) { l0 = atomicAdd((int*)(lcnt + x0), 1); l1 = atomicAdd((int*)(lcnt + x1), 1); }
        }
        __syncthreads();
        if (!DRY && tid < 64) { const int c = lcnt[tid]; lcnt[64 + tid] = c ? (int)atomicAdd(p.cnt + tid, (unsigned)c) : 0; }
        __syncthreads();
        if (!DRY && lane < 16) {
            const int xr = xr0 + lane, r0 = lcnt[64 + x0] + l0, r1 = lcnt[64 + x1] + l1;
            p.rstd[xr] = rs;
            p.list[(size_t)x0 * NX + r0] = xr; p.list[(size_t)x1 * NX + r1] = xr; p.rsl[(size_t)x0 * NX + r0] = rs; p.rsl[(size_t)x1 * NX + r1] = rs;
            p.asg_e[xr * 2] = x0; p.asg_e[xr * 2 + 1] = x1; p.asg_rank[xr * 2] = r0; p.asg_rank[xr * 2 + 1] = r1;
            p.asg_gate[xr * 2] = gate0; p.asg_gate[xr * 2 + 1] = gate1;
        }
    }
    __syncthreads();
}

__device__ __forceinline__ void moe_tables(const P& p, int* tb) {
    __syncthreads();
    if (threadIdx.x < NE) tb[threadIdx.x] = (int)xb_ld(p.cnt + threadIdx.x);
    __syncthreads();
    if (threadIdx.x == 0) {
        int s = 0, nt = 0;
        for (int e = 0; e < NE; ++e) { const int c = tb[e]; tb[64 + e] = s;
            for (int j = 0; j < (c + 255) / 256; ++j) { tb[192 + nt] = e; tb[512 + nt] = j * 256; ++nt; }
            s += (c + 255) / 256 * 256; }
        tb[128] = s; tb[129] = nt;
    }
    __syncthreads();
}
struct MoeOrder { const int* tb; int G, c;
    __device__ __forceinline__ bool next(int i, Unit& u) const {
        int rt, pn;
        if ((G & 31) == 0) { const int x = c & 7, q = c >> 3; rt = i * (G >> 2) + x * (G >> 5) + (q >> 2); pn = q & 3; }
        else { const int Lx = i * G + c; rt = Lx >> 2; pn = Lx & 3; }
        if (rt >= tb[129]) return false;
        u.pm = rt; u.pn = pn; u.e = tb[192 + rt]; u.r0 = tb[512 + rt]; return true; } };
struct GMoe1 { const char* A; int kstepA, K; const char* Bt; const int* list; const int* tb;
    __device__ __forceinline__ unsigned aoff(const Unit& u, int r, int C) const { const int rr = u.r0 + r; const int xr = rr < tb[u.e] ? list[(size_t)u.e * NX + rr] : 0; return (unsigned)xr * (D * 2) + (unsigned)(C * 2); }
    __device__ __forceinline__ const char* bptr(const Unit& u) const { return Bt + ((size_t)u.e * 1024 + (size_t)u.pn * BM) * D * 2; } };
struct EpiMoe1 { static constexpr int KIND = 3; bf16* hid; const float* rsl; const int* tb;
    __device__ __forceinline__ void operator()(const f32x4 (&acc)[2][2][4][2], const Unit& u, int wr, int wc, int fr, int fq) const {
        const int cnt = tb[u.e], s0 = tb[64 + u.e] + u.r0;
#pragma unroll
        for (int ai = 0; ai < 2; ++ai)
#pragma unroll
            for (int m = 0; m < 4; ++m) { const int r = ai * HALF + wr * 64 + m * 16 + fr, rr = u.r0 + r; const float rs = rr < cnt ? rsl[(size_t)u.e * NX + rr] : 0.f;
#pragma unroll
                for (int n = 0; n < 2; ++n) { const f32x4 gt = acc[ai][0][m][n] * rs, up = acc[ai][1][m][n] * rs; uint2 o;
                    o.x = cvt_pk_bf16(siluf_(gt[0]) * up[0], siluf_(gt[1]) * up[1]); o.y = cvt_pk_bf16(siluf_(gt[2]) * up[2], siluf_(gt[3]) * up[3]); *(uint2*)(hid + blk16(s0 + r, u.pn * HALF + wc * 32 + n * 16 + 4 * fq, DE / 16)) = o; } }
    } };
__device__ __forceinline__ void ph_moe1(const P& p, LAS unsigned char* lds, const int* tb) {
    GMoe1 g{(const char*)p.h1, BK * 2, D, (const char*)p.Wgu, p.list, tb}; MoeOrder S{tb, (int)gridDim.x, (int)blockIdx.x}; EpiMoe1 E{p.hid, p.rsl, tb};
    gemm_phase(lds, g, S, E);
}
struct GMoe2 { const char* A; int kstepA, K; const char* Bt; const int* tb;
    __device__ __forceinline__ unsigned aoff(const Unit& u, int r, int C) const { return (unsigned)(blk16(tb[64 + u.e] + u.r0 + r, C, DE / 16) * 2); }
    __device__ __forceinline__ const char* bptr(const Unit& u) const { return Bt + ((size_t)u.e * 1024 + (size_t)u.pn * BM) * DE * 2; } };
struct EpiMoe2 { static constexpr int KIND = 4; bf16* y; const int* tb;
    __device__ __forceinline__ void operator()(const f32x4 (&acc)[2][2][4][2], const Unit& u, int wr, int wc, int fr, int fq) const {
        const int s0 = tb[64 + u.e] + u.r0;
#pragma unroll
        for (int ai = 0; ai < 2; ++ai)
#pragma unroll
            for (int m = 0; m < 4; ++m) { const int row = s0 + ai * HALF + wr * 64 + m * 16 + fr, col0 = u.pn * BM + wc * 32 + 4 * fq;
#pragma unroll
                for (int bj = 0; bj < 2; ++bj)
#pragma unroll
                    for (int n = 0; n < 2; ++n) { const f32x4 v = acc[ai][bj][m][n]; uint2 o; o.x = cvt_pk_bf16(v[0], v[1]); o.y = cvt_pk_bf16(v[2], v[3]); *(uint2*)(y + (size_t)row * D + col0 + bj * HALF + n * 16) = o; } }
    } };
__device__ __forceinline__ void ph_moe2(const P& p, LAS unsigned char* lds, const int* tb) {
    GMoe2 g{(const char*)p.hid, 4 * 512, DE, (const char*)p.Wd, tb}; MoeOrder S{tb, (int)gridDim.x, (int)blockIdx.x}; EpiMoe2 E{p.y, tb};
    gemm_phase(lds, g, S, E);
}
__device__ __forceinline__ void ph_final(const P& p, const int* tb) {
    const int* soff = tb + 64;
    int tid_ = threadIdx.x; asm volatile("" : "+v"(tid_));
    const int lane = tid_ & 63, wpb = blockDim.x >> 6;
    const int wave = blockIdx.x * wpb + (tid_ >> 6), nw = gridDim.x * wpb;
    float gn[16];
#pragma unroll
    for (int q = 0; q < 4; ++q) { const float4 g4 = ((const float4*)p.norm_final)[lane * 4 + q]; gn[4 * q] = g4.x; gn[4 * q + 1] = g4.y; gn[4 * q + 2] = g4.z; gn[4 * q + 3] = g4.w; }
    const bool bad = xb_ld(p.bar + XB_TMO) != 0u;
    for (int xr0 = wave; xr0 < NX; xr0 += 2 * nw) {
        const int xrs[2] = {xr0, xr0 + nw < NX ? xr0 + nw : xr0};
        u32x4 hv[2][2], av[2][2], cv[2][2]; float g0[2], g1[2];
#pragma unroll
        for (int q = 0; q < 2; ++q) {
            const int xr = xrs[q];
            const int s0 = soff[p.asg_e[xr * 2]] + p.asg_rank[xr * 2], s1 = soff[p.asg_e[xr * 2 + 1]] + p.asg_rank[xr * 2 + 1];
            g0[q] = p.asg_gate[xr * 2]; g1[q] = p.asg_gate[xr * 2 + 1];
            const bf16* hp = p.h1 + (size_t)xr * D + 16 * lane; const bf16* y0 = p.y + (size_t)s0 * D + 16 * lane; const bf16* y1 = p.y + (size_t)s1 * D + 16 * lane;
            hv[q][0] = *(const u32x4*)hp; hv[q][1] = *(const u32x4*)(hp + 8); av[q][0] = *(const u32x4*)y0; av[q][1] = *(const u32x4*)(y0 + 8); cv[q][0] = *(const u32x4*)y1; cv[q][1] = *(const u32x4*)(y1 + 8);
        }
#pragma unroll
        for (int q = 0; q < 2; ++q) {
            float v[16]; float ss = 0.f;
#pragma unroll
            for (int hq = 0; hq < 2; ++hq) {
                const unsigned hw[4] = {hv[q][hq].x, hv[q][hq].y, hv[q][hq].z, hv[q][hq].w}, aw[4] = {av[q][hq].x, av[q][hq].y, av[q][hq].z, av[q][hq].w}, cw[4] = {cv[q][hq].x, cv[q][hq].y, cv[q][hq].z, cv[q][hq].w};
#pragma unroll
                for (int e = 0; e < 4; ++e) { v[8 * hq + 2 * e] = bflo(hw[e]) + g0[q] * bflo(aw[e]) + g1[q] * bflo(cw[e]); v[8 * hq + 2 * e + 1] = bfhi(hw[e]) + g0[q] * bfhi(aw[e]) + g1[q] * bfhi(cw[e]); }
            }
#pragma unroll
            for (int e = 0; e < 16; ++e) ss += v[e] * v[e];
            ss = wave_sum(ss);
            float r = rsqrtf(ss * (1.0f / D) + EPS);
            if (bad) r = __builtin_nanf("");
            float* op = p.out + (size_t)xrs[q] * D + 16 * lane;
#pragma unroll
            for (int e4 = 0; e4 < 4; ++e4) *(float4*)(op + 4 * e4) = make_float4(v[4 * e4] * r * gn[4 * e4], v[4 * e4 + 1] * r * gn[4 * e4 + 1], v[4 * e4 + 2] * r * gn[4 * e4 + 2], v[4 * e4 + 3] * r * gn[4 * e4 + 3]);
        }
    }
}

constexpr int LDS_SCR = HY_END > STAGE_BYTES ? HY_END : STAGE_BYTES;
constexpr int LDS_BAR = LDS_SCR, LDS_TB = LDS_SCR + 64, LDS_BYTES = LDS_SCR + 64 + 4096;
static_assert(LDS_BYTES <= 160 * 1024 && HG_END <= LDS_SCR, "LDS");

__global__ void __launch_bounds__(512, 2) k_mega(P p) {
    extern __shared__ __attribute__((aligned(16))) unsigned char smraw[];
    float* sm = (float*)smraw;
    LAS unsigned char* lds = (LAS unsigned char*)smraw;
    int* tb = (int*)(smraw + LDS_TB);
    if (threadIdx.x == 0) *(uint4*)(smraw + LDS_BAR) = make_uint4(0u, 0u, 0u, 0u);
    __syncthreads();
    XcdBarrier bar = xcd_barrier_post(p.bar, (volatile LAS unsigned*)(smraw + LDS_BAR));
    ph_norm1(p);
    ph_conv<1>(p, sm, 0, 3);
    ph_conv_router(p);
    ph_filters(p, sm);
    xcd_barrier(bar);
    const int sg = (blockIdx.x >> 3) & 3;
    ph_conv<2>(p, sm, 0, (4 / 4) * sg);
    ph_inproj(p, lds);
    ph_conv<2>(p, sm, (4 / 4) * sg, 4);
    xcd_barrier(bar);
    ph_mixers(p, lds, (LAS int*)(smraw + LDS_TB));
    xcd_barrier(bar);
    ph_buildA2(p, lds);
    xcd_barrier(bar);
    ph_conv<0>(p, sm, 0, 8 * sg);
    ph_outproj(p, lds);
    ph_conv<0>(p, sm, 8 * sg, 1 << 20);
    xcd_barrier(bar);
    ph_router<false>(p, lds);
    xcd_barrier(bar);
    moe_tables(p, tb);
    ph_moe1(p, lds, tb);
    xcd_barrier(bar);
    ph_moe2(p, lds, tb);
    xcd_barrier(bar);
    ph_final(p, tb);
}

struct Alloc { size_t off = 0; size_t take(size_t bytes) { const size_t o = off; off += (bytes + 255) & ~(size_t)255; return o; } };
}

extern "C" void kernel_launch(void* const* d_in, const int* in_sizes, int n_in, void* d_out, int out_size, void* d_ws, size_t ws_size, hipStream_t stream) {
    (void)in_sizes; (void)n_in; (void)out_size;
    char* ws = (char*)d_ws;
    P p{};
    const float** ins[] = {&p.x, &p.meta, &p.w_in, &p.conv_w, &p.conv_b, &p.fw1, &p.fb1, &p.fw2, &p.fb2, &p.fw3, &p.ffreq, &p.fskip, &p.hy_norm, &p.lb_f, &p.lb_b,
                           &p.hg_norm, &p.w_out, &p.norm_mix, &p.norm_ffn, &p.w_rg, &p.w_re, &p.w_gate, &p.w_up, &p.w_down, &p.norm_final};
    for (int i = 0; i < 25; ++i) *ins[i] = (const float*)d_in[i];
    p.out = (float*)d_out;
    Alloc a;
    const size_t o_zero = a.take(65536);
    const size_t o_A = a.take((size_t)NX * D * 2);
    const size_t o_Preg = a.off;
    const size_t o_pT = a.take((size_t)NHY * BATCH * LP * 2);
    const size_t o_pg = a.take((size_t)NTOK * NHG * 2);
    const size_t o_G = a.take((size_t)1024 * GL * 2);
    const size_t o_W1t = a.take((size_t)NPROJ * D * 2);
    const size_t o_Hreg = a.off;
    const size_t o_z2 = a.take((size_t)DH * BATCH * LP * 2);
    const size_t o_o = a.take((size_t)2 * NTOK * DG * 2);
    if (a.off < o_Hreg + (size_t)NX * D * 2) a.off = o_Hreg + (size_t)NX * D * 2;
    const size_t o_W2t = a.take((size_t)D * D * 2);
    const size_t o_Wd = a.take((size_t)NE * 1024 * DE * 2);
    const size_t o_Wr = a.take((size_t)2 * 80 * 1024 * 2);
    const size_t o_Am = a.take((size_t)NMETA * D * 2);
    const size_t o_list = a.take((size_t)NE * NX * 4);
    const size_t o_rstd = a.take((size_t)NX * 4);
    const size_t o_rsl = a.take((size_t)NE * NX * 4);
    const size_t o_ae = a.take((size_t)NX * 2 * 4), o_ar = a.take((size_t)NX * 2 * 4), o_ag = a.take((size_t)NX * 2 * 4);
    const size_t sz_wgu = (size_t)NE * 1024 * 1024 * 2, sz_hid = (size_t)MAXSLOT * DE * 2, sz_wd = (size_t)NE * 1024 * DE * 2, sz_y = (size_t)MAXSLOT * D * 2;
    const size_t o_Wgu = o_Preg, o_hid = o_Wgu + sz_wgu, o_y = o_A, o_h1 = o_Hreg;
    (void)sz_wd;
    if (a.off > ws_size || o_hid + sz_hid > o_G || o_y + sz_y > o_Wgu + sz_wgu || o_h1 + (size_t)NX * D * 2 > o_W2t) {
        fprintf(stderr, "workspace map does not fit: need %zu have %zu\n", a.off, ws_size); return; }
    p.bar = (unsigned*)(ws + o_zero); p.cnt = p.bar + 8192;
    p.A = (bf16*)(ws + o_A); p.pT = (bf16*)(ws + o_pT); p.pg = (bf16*)(ws + o_pg); p.G = (bf16*)(ws + o_G); p.z2 = (bf16*)(ws + o_z2); p.o = (bf16*)(ws + o_o);
    p.h1 = (bf16*)(ws + o_h1); p.rstd = (float*)(ws + o_rstd); p.list = (int*)(ws + o_list); p.rsl = (float*)(ws + o_rsl); p.asg_e = (int*)(ws + o_ae); p.asg_rank = (int*)(ws + o_ar); p.asg_gate = (float*)(ws + o_ag);
    p.hid = (bf16*)(ws + o_hid); p.y = (bf16*)(ws + o_y);
    p.W1t = (bf16*)(ws + o_W1t); p.W2t = (bf16*)(ws + o_W2t); p.Wgu = (bf16*)(ws + o_Wgu); p.Wd = (bf16*)(ws + o_Wd); p.Wr = (bf16*)(ws + o_Wr); p.Am = (bf16*)(ws + o_Am);
    hipMemsetAsync(ws + o_zero, 0, 65536, stream);
    static int grid = 0;
    if (!grid) {
        int dev = 0, cus = 0, per_cu = 0;
        hipGetDevice(&dev);
        hipDeviceGetAttribute(&cus, hipDeviceAttributeMultiprocessorCount, dev);
        if (hipFuncSetAttribute((const void*)k_mega, hipFuncAttributeMaxDynamicSharedMemorySize, LDS_BYTES) != hipSuccess) { fprintf(stderr, "hipFuncSetAttribute failed\n"); return; }
        hipOccupancyMaxActiveBlocksPerMultiprocessor(&per_cu, (const void*)k_mega, 512, LDS_BYTES);
        if (per_cu < 1) { fprintf(stderr, "occupancy query says 0 blocks per CU\n"); return; }
        grid = cus;
    }
    k_mega<<<grid, 512, LDS_BYTES, stream>>>(p);
}
```

```cpp
#include <hip/hip_runtime.h>
#include <stdint.h>
#include <stdio.h>

namespace {
typedef unsigned short bf16;

constexpr int D = 1024, BATCH = 16, SEQ = 2048, NMETA = 16, L = SEQ + NMETA;
constexpr int NTOK = BATCH * L;
constexpr int NX = BATCH * SEQ;
constexpr int DH = 512, DG = 512, NHY = 1536, NHG = 2560, NPROJ = 4096;
constexpr int LP = 2080;
constexpr int GL = 4160;
constexpr int NE = 64, DE = 512;
constexpr int MAXSLOT = NX * 2 + NE * 256;
constexpr float EPS = 1e-6f;

__device__ __forceinline__ bf16 f2bf(float f) { unsigned u = __float_as_uint(f); u += 0x7FFFu + ((u >> 16) & 1u); return (bf16)(u >> 16); }
__device__ __forceinline__ float bf2f(bf16 b) { return __uint_as_float(((unsigned)b) << 16); }
__device__ __forceinline__ float wave_sum(float v) {
#pragma unroll
    for (int o = 32; o >= 1; o >>= 1) v += __shfl_xor(v, o);
    return v;
}
__device__ __forceinline__ float sigmoidf_(float x) { return 1.0f / (1.0f + __expf(-x)); }
__device__ __forceinline__ float siluf_(float x) { return x * __builtin_amdgcn_rcpf(1.0f + __builtin_amdgcn_exp2f(-1.44269504f * x)); }

#define XB_TMO      128
#define XB_XCNT(j)  (256  + 64 * (j))
#define XB_XSUB(j)  (1280 + 64 * (j))
#define XB_XGEN(j)  (2304 + 64 * (j))
#define XB_TOP      3328
#define XB_TOPGEN   3392
#define XCD_BAR_WORDS 3456
#define XB_SPIN_CAP (1u << 21)
#define LAS __attribute__((address_space(3)))

__device__ __forceinline__ unsigned xb_ld(unsigned* p)              { return __hip_atomic_load(p, __ATOMIC_RELAXED, __HIP_MEMORY_SCOPE_AGENT); }
__device__ __forceinline__ unsigned xb_add(unsigned* p, unsigned v) { return __hip_atomic_fetch_add(p, v, __ATOMIC_RELAXED, __HIP_MEMORY_SCOPE_AGENT); }
__device__ __forceinline__ unsigned xb_xcc_id() { return (unsigned)__builtin_amdgcn_s_getreg((3 << 11) | 20) & 0xFu; }
#define XB_SPIN(cond, bar) do { unsigned _sp = 0; while (cond) { __builtin_amdgcn_s_sleep(1); \
    if ((++_sp & 255u) == 0u) { if (xb_ld(&(bar)[XB_TMO])) break; if (_sp > XB_SPIN_CAP) { atomicAdd(&(bar)[XB_TMO], 1u); break; } } } } while (0)

struct XcdBarrier {
    unsigned* bar; unsigned x;
    volatile LAS unsigned* st;
};

__device__ __forceinline__ XcdBarrier xcd_barrier_post(unsigned* bar, volatile LAS unsigned* st) {
    XcdBarrier b; b.bar = bar; b.x = xb_xcc_id(); b.st = st;
    if (threadIdx.x == 0) (void)xb_add(&bar[XB_XCNT(b.x)], 1u);
    return b;
}
__device__ __forceinline__ void xcd_barrier_complete(unsigned* bar, unsigned x, unsigned& nloc, unsigned& nx) {
    const unsigned G = gridDim.x * gridDim.y * gridDim.z;
    unsigned sum, cnt, mine, sp = 0u;
    for (;;) {
        sum = 0u; cnt = 0u; mine = 0u;
#pragma unroll
        for (unsigned j = 0; j < 16; ++j) { const unsigned c = xb_ld(&bar[XB_XCNT(j)]); sum += c; cnt += (c > 0u) ? 1u : 0u; mine = (j == x) ? c : mine; }
        if (sum == G) break;
        __builtin_amdgcn_s_sleep(1);
        if ((++sp & 255u) == 0u) { if (xb_ld(&bar[XB_TMO])) break; if (sp > XB_SPIN_CAP) { atomicAdd(&bar[XB_TMO], 1u); break; } }
    }
    nloc = mine > 0u ? mine : 1u; nx = cnt > 0u ? cnt : 1u;
}

__device__ __forceinline__ void xcd_barrier(const XcdBarrier& b) {
    asm volatile("s_waitcnt vmcnt(0)" ::: "memory");
    __syncthreads();
    if (threadIdx.x == 0) {
        unsigned* bar = b.bar;
        __builtin_amdgcn_s_waitcnt(0);
        unsigned nloc = b.st[0], nx = b.st[1];
        if (nloc == 0u) { xcd_barrier_complete(bar, b.x, nloc, nx); b.st[0] = nloc; b.st[1] = nx; }
        const unsigned old = xb_add(&bar[XB_XSUB(b.x)], 1u);
        const unsigned gen = old / nloc;
        if (old + 1u == (gen + 1u) * nloc) {
            __builtin_amdgcn_fence(__ATOMIC_RELEASE, "agent");
            asm volatile("s_waitcnt vmcnt(0)" ::: "memory");
            const unsigned og = xb_add(&bar[XB_TOP], 1u);
            const unsigned tg = og / nx;
            if (og + 1u == (tg + 1u) * nx) xb_add(&bar[XB_TOPGEN], 1u);
            else XB_SPIN(xb_ld(&bar[XB_TOPGEN]) == tg, bar);
            __builtin_amdgcn_fence(__ATOMIC_ACQUIRE, "agent");
            xb_add(&bar[XB_XGEN(b.x)], 1u);
            asm volatile("s_waitcnt vmcnt(0)" ::: "memory");
        } else {
            XB_SPIN(xb_ld(&bar[XB_XGEN(b.x)]) == gen, bar);
            __builtin_amdgcn_fence(__ATOMIC_ACQUIRE, "agent");
            asm volatile("s_waitcnt vmcnt(0)" ::: "memory");
        }
    }
    __syncthreads();
}


struct P {
    const float *x, *meta, *w_in, *conv_w, *conv_b, *fw1, *fb1, *fw2, *fb2, *fw3, *ffreq, *fskip, *hy_norm, *lb_f, *lb_b, *hg_norm,
        *w_out, *norm_mix, *norm_ffn, *w_rg, *w_re, *w_gate, *w_up, *w_down, *norm_final;
    float* out;
    unsigned* bar;
    unsigned* cnt;
    bf16* A;
    bf16* Am;
    bf16* pT;
    bf16* pg;
    bf16* G;
    bf16* z2;
    bf16* o;
    bf16* h1;
    float* rstd;
    int* list;
    float* rsl;
    int* asg_e;
    int* asg_rank;
    float* asg_gate;
    bf16* hid;
    bf16* y;
    bf16 *W1t, *W2t, *Wgu, *Wd;
    bf16* Wr;
};

__device__ __forceinline__ void ph_norm1(const P& p) {
    int tid_ = threadIdx.x; asm volatile("" : "+v"(tid_));
    const int lane = tid_ & 63, wpb = blockDim.x >> 6;
    const int wave = blockIdx.x * wpb + (tid_ >> 6), nw = gridDim.x * wpb;
    float4 gn[4];
#pragma unroll
    for (int i = 0; i < 4; ++i) gn[i] = ((const float4*)p.norm_mix)[i * 64 + lane];
    constexpr int NR = NX + NMETA;
    for (int tok = wave; tok < NR; tok += 4 * nw) {
        int tk[4];
#pragma unroll
        for (int q = 0; q < 4; ++q) tk[q] = tok + q * nw < NR ? tok + q * nw : tok;
        float4 v[4][4]; float ss[4];
#pragma unroll
        for (int q = 0; q < 4; ++q) {
            const float* src = tk[q] >= NX ? p.meta + (size_t)(tk[q] - NX) * D : p.x + (size_t)tk[q] * D;
#pragma unroll
            for (int i = 0; i < 4; ++i) v[q][i] = ((const float4*)src)[i * 64 + lane];
        }
#pragma unroll
        for (int q = 0; q < 4; ++q) { float s = 0.f;
#pragma unroll
            for (int i = 0; i < 4; ++i) s += v[q][i].x * v[q][i].x + v[q][i].y * v[q][i].y + v[q][i].z * v[q][i].z + v[q][i].w * v[q][i].w;
            ss[q] = wave_sum(s); }
#pragma unroll
        for (int q = 0; q < 4; ++q) {
            const float r = rsqrtf(ss[q] * (1.0f / D) + EPS);
            bf16* dst = tk[q] >= NX ? p.Am + (size_t)(tk[q] - NX) * D : p.A + (size_t)tk[q] * D;
#pragma unroll
            for (int i = 0; i < 4; ++i) {
                ushort4 o; o.x = f2bf(v[q][i].x * r * gn[i].x); o.y = f2bf(v[q][i].y * r * gn[i].y); o.z = f2bf(v[q][i].z * r * gn[i].z); o.w = f2bf(v[q][i].w * r * gn[i].w);
                ((ushort4*)dst)[i * 64 + lane] = o;
            }
        }
    }
}

typedef short bf16x8 __attribute__((ext_vector_type(8)));
typedef float f32x4 __attribute__((ext_vector_type(4)));
typedef unsigned u32x4 __attribute__((ext_vector_type(4)));
typedef unsigned u32x2 __attribute__((ext_vector_type(2)));
constexpr int BM = 256, BK = 64, HALF = 128, HTB = HALF * BK * 2, STAGE_BYTES = 8 * HTB;
__device__ __forceinline__ int lds_byte(int r, int c) { const int st = (r >> 4) * 2 + (c >> 5), rr = r & 15, cc = c & 31, ob = rr * 64 + cc * 2; return st * 1024 + (ob ^ (((ob >> 9) & 1) << 5)); }
__device__ __forceinline__ void stage_rc(int b, int& R, int& C) { const int st = b / 1024, sb = b % 1024, swz = sb ^ (((sb >> 9) & 1) << 5); R = (st >> 1) * 16 + swz / 64; C = (st & 1) * 32 + (swz % 64) / 2; }
__device__ __forceinline__ int perm32(int rho) { const int n = rho >> 4, i = rho & 15; return 8 * (i >> 2) + 4 * n + (i & 3); }
__device__ __forceinline__ unsigned cvt_pk_bf16(float lo, float hi) { unsigned r; asm volatile("v_cvt_pk_bf16_f32 %0, %1, %2" : "=v"(r) : "v"(lo), "v"(hi)); return r; }

__device__ __forceinline__ float4 ld_bf4(const bf16* p) { const ushort4 u = *(const ushort4*)p; return make_float4(bf2f(u.x), bf2f(u.y), bf2f(u.z), bf2f(u.w)); }
__device__ __forceinline__ size_t blk16(int r, int c, int ncb) { return ((size_t)(r >> 4) * ncb + (c >> 4)) * 256 + (r & 15) * 16 + (c & 15); }
struct Unit { int pm, pn, e, r0; };
struct StaticOrder {
    int nM, nN, nwg, G, c;
    __device__ void init(int nM_, int nN_, int G_, int c_) { nM = nM_; nN = nN_; nwg = nM * nN; G = G_; c = c_; }
    __device__ bool next(int i, Unit& u) const {
        const long Lx = (long)i * G + c; if (Lx >= nwg) return false;
        int wgid = (int)Lx; { const int q = nwg / 8, r = nwg % 8, xcd = wgid % 8, off = wgid / 8; wgid = (xcd < r ? xcd * (q + 1) : r * (q + 1) + (xcd - r) * q) + off; }
        const int nig = 8 * nN, gid = wgid / nig, fm = gid * 8, gsz = (nM - fm) < 8 ? (nM - fm) : 8;
        u.pm = fm + ((wgid % nig) % gsz); u.pn = (wgid % nig) / gsz; u.e = 0; u.r0 = 0; return true;
    }
};

template <class GC, class Sched, class Epi>
__device__ __forceinline__ void gemm_phase(LAS unsigned char* lds, const GC& g, const Sched& S, const Epi& E) {
    int tid_ = threadIdx.x; asm volatile("" : "+v"(tid_));
    const int tid = tid_, wid = __builtin_amdgcn_readfirstlane(tid >> 6), lane = tid & 63, wr = wid >> 2, wc = wid & 3, fr = lane & 15, fq = lane >> 4;
    const int K = g.K, nt = K / BK;
    int Rr[2], Cc[2]; unsigned voffB[2];
#pragma unroll
    for (int i = 0; i < 2; ++i) { stage_rc(tid * 16 + i * 8192, Rr[i], Cc[i]);
        const int Rb = Epi::PERM ? ((Rr[i] & ~31) + perm32(Rr[i] & 31)) : Rr[i]; voffB[i] = (unsigned)(Rb * K + Cc[i]) * 2u; }
    const size_t kstep = (size_t)(BK * 2), kstepA = (size_t)g.kstepA;
    const size_t hstepB = (size_t)HALF * K * 2;
    const unsigned ldsw = (unsigned)wid * 1024u;
    const int aoff = lds_byte(wr * 64 + fr, fq * 8), boff = lds_byte(wc * 32 + fr, fq * 8);
#define PG8_SA(b, h) (((b) * 2 + (h)) * HTB)
#define PG8_SB(b, h) ((4 + (b) * 2 + (h)) * HTB)
#define PG8_STAGE(bufoff, gbase, voff) do { _Pragma("unroll") for (int _i = 0; _i < 2; ++_i) \
        __builtin_amdgcn_global_load_lds((const unsigned*)((const char*)(gbase) + (voff)[_i]), (LAS unsigned*)(lds + (bufoff) + ldsw + _i * 8192), 16, 0, 0); } while (0)
#define PG8_LDA(dst, b, h) do { _Pragma("unroll") for (int m = 0; m < 4; ++m) _Pragma("unroll") for (int k = 0; k < 2; ++k) dst[m][k] = *(const LAS bf16x8*)(lds + PG8_SA(b, h) + aoff + m * 2048 + k * 1024); } while (0)
#define PG8_LDB(dst, b, h) do { _Pragma("unroll") for (int n = 0; n < 2; ++n) _Pragma("unroll") for (int k = 0; k < 2; ++k) dst[n][k] = *(const LAS bf16x8*)(lds + PG8_SB(b, h) + boff + n * 2048 + k * 1024); } while (0)
#define PG8_MMA(ai, bj, At, Bt) do { __builtin_amdgcn_s_setprio(1); _Pragma("unroll") for (int m = 0; m < 4; ++m) _Pragma("unroll") for (int n = 0; n < 2; ++n) _Pragma("unroll") for (int k = 0; k < 2; ++k) \
        acc[ai][bj][m][n] = __builtin_amdgcn_mfma_f32_16x16x32_bf16(Bt[n][k], At[m][k], acc[ai][bj][m][n], 0, 0, 0); __builtin_amdgcn_s_setprio(0); } while (0)
#define PG8_WAIT_V(n) asm volatile("s_waitcnt vmcnt(" #n ")" ::: "memory")
#define PG8_WAIT_L(n) asm volatile("s_waitcnt lgkmcnt(" #n ")" ::: "memory")
#define PG8_BAR __builtin_amdgcn_s_barrier()
#define PG8_SCHED __builtin_amdgcn_sched_barrier(0)
    Unit cur, nxt; int ui = 0;
    if (!S.next(0, cur)) return;
    f32x4 acc[2][2][4][2];
#pragma unroll
    for (int a = 0; a < 2; ++a)
#pragma unroll
        for (int b = 0; b < 2; ++b)
#pragma unroll
            for (int m = 0; m < 4; ++m)
#pragma unroll
                for (int n = 0; n < 2; ++n) acc[a][b][m][n] = (f32x4){0.f, 0.f, 0.f, 0.f};
    bf16x8 At[4][2], B0[2][2], B1[2][2];
    unsigned ca[2][2], na[2][2];
#pragma unroll
    for (int h = 0; h < 2; ++h)
#pragma unroll
        for (int i = 0; i < 2; ++i) ca[h][i] = g.aoff(cur, h * HALF + Rr[i], Cc[i]);
    const char* const A0 = g.A;
    const char* cB = g.bptr(cur);
    PG8_STAGE(PG8_SB(0, 0), cB, voffB); PG8_STAGE(PG8_SA(0, 0), A0, ca[0]); PG8_STAGE(PG8_SB(0, 1), cB + hstepB, voffB); PG8_STAGE(PG8_SA(0, 1), A0, ca[1]);
    if (wr == 1) PG8_BAR;
    PG8_WAIT_V(4); PG8_BAR;
    PG8_STAGE(PG8_SB(1, 0), cB + kstep, voffB); PG8_STAGE(PG8_SA(1, 0), A0 + kstepA, ca[0]); PG8_STAGE(PG8_SB(1, 1), cB + hstepB + kstep, voffB);
    PG8_WAIT_V(6); PG8_BAR;
    for (;;) {
        const bool has_next = S.next(ui + 1, nxt);
        const char* nB = cB;
#pragma unroll
        for (int h = 0; h < 2; ++h)
#pragma unroll
            for (int i = 0; i < 2; ++i) na[h][i] = ca[h][i];
        if (has_next) {
            nB = g.bptr(nxt);
            if (GC::GATHER) {
#pragma unroll
                for (int h = 0; h < 2; ++h)
#pragma unroll
                    for (int i = 0; i < 2; ++i) na[h][i] = g.aoff(nxt, h * HALF + Rr[i], Cc[i]);
            }
        }
        for (int t = 0; t < nt; t += 2) {
            const bool last = (t == nt - 2);
            const char* a1 = A0 + (size_t)(t + 1) * kstepA;
            const char* a2 = last ? A0 : A0 + (size_t)(t + 2) * kstepA; const char* b2 = last ? nB : cB + (size_t)(t + 2) * kstep;
            const char* a3 = a2 + kstepA; const char* b3 = b2 + kstep;
            unsigned s0[2], s1[2];
            if (!GC::GATHER && last && has_next) {
#pragma unroll
                for (int h = 0; h < 2; ++h)
#pragma unroll
                    for (int i = 0; i < 2; ++i) na[h][i] = g.aoff(nxt, h * HALF + Rr[i], Cc[i]);
            }
            s0[0] = last ? na[0][0] : ca[0][0]; s0[1] = last ? na[0][1] : ca[0][1]; s1[0] = last ? na[1][0] : ca[1][0]; s1[1] = last ? na[1][1] : ca[1][1];
            PG8_LDB(B0, 0, 0); PG8_SCHED; PG8_LDA(At, 0, 0); PG8_STAGE(PG8_SA(1, 1), a1, ca[1]);
            PG8_WAIT_L(8); PG8_BAR; PG8_WAIT_L(0); PG8_MMA(0, 0, At, B0); PG8_BAR; PG8_SCHED;
            PG8_LDB(B1, 0, 1); PG8_STAGE(PG8_SB(0, 0), b2, voffB);
            PG8_BAR; PG8_WAIT_L(0); PG8_MMA(0, 1, At, B1); PG8_BAR;
            PG8_LDA(At, 0, 1); PG8_STAGE(PG8_SA(0, 0), a2, s0);
            PG8_BAR; PG8_WAIT_L(0); PG8_MMA(1, 0, At, B0); PG8_BAR; PG8_SCHED;
            PG8_STAGE(PG8_SB(0, 1), b2 + hstepB, voffB);
            PG8_WAIT_V(6); PG8_BAR; PG8_MMA(1, 1, At, B1); PG8_BAR;
            PG8_LDB(B0, 1, 0); PG8_SCHED; PG8_LDA(At, 1, 0); PG8_STAGE(PG8_SA(0, 1), a2, s1);
            PG8_WAIT_L(8); PG8_BAR; PG8_WAIT_L(0); PG8_MMA(0, 0, At, B0); PG8_BAR; PG8_SCHED;
            PG8_LDB(B1, 1, 1); PG8_STAGE(PG8_SB(1, 0), b3, voffB);
            PG8_BAR; PG8_WAIT_L(0); PG8_MMA(0, 1, At, B1); PG8_BAR;
            PG8_LDA(At, 1, 1); PG8_STAGE(PG8_SA(1, 0), a3, s0);
            PG8_BAR; PG8_WAIT_L(0); PG8_MMA(1, 0, At, B0); PG8_BAR; PG8_SCHED;
            PG8_STAGE(PG8_SB(1, 1), b3 + hstepB, voffB);
            PG8_WAIT_V(6); PG8_BAR; PG8_MMA(1, 1, At, B1); PG8_BAR;
        }
        E(acc, cur, wr, wc, fr, fq);
        if (!has_next) break;
#pragma unroll
        for (int a = 0; a < 2; ++a)
#pragma unroll
            for (int b = 0; b < 2; ++b)
#pragma unroll
                for (int m = 0; m < 4; ++m)
#pragma unroll
                    for (int n = 0; n < 2; ++n) acc[a][b][m][n] = (f32x4){0.f, 0.f, 0.f, 0.f};
        cur = nxt; cB = nB; ++ui;
#pragma unroll
        for (int h = 0; h < 2; ++h)
#pragma unroll
            for (int i = 0; i < 2; ++i) ca[h][i] = na[h][i];
    }
    PG8_WAIT_V(0);
    if (wr == 0) PG8_BAR;
    PG8_BAR;
#undef PG8_SA
#undef PG8_SB
#undef PG8_STAGE
#undef PG8_LDA
#undef PG8_LDB
#undef PG8_MMA
#undef PG8_WAIT_V
#undef PG8_WAIT_L
#undef PG8_BAR
#undef PG8_SCHED
}

template <class RM>
__device__ __forceinline__ void tconv_tile(const float* src, int ldn, int k0, int n0, bf16* dst, int ldd, RM rm, float* tile, const float* kscale = nullptr) {
    const int tid = threadIdx.x;
    __syncthreads();
    for (int idx = tid; idx < 1024; idx += blockDim.x) {
        const int kk = idx >> 4, nq = (idx & 15) * 4; float4 v = *(const float4*)(src + (size_t)(k0 + kk) * ldn + n0 + nq);
        if (kscale) { const float s = kscale[k0 + kk]; v.x *= s; v.y *= s; v.z *= s; v.w *= s; }
        float* tp = tile + kk * 65 + nq; tp[0] = v.x; tp[1] = v.y; tp[2] = v.z; tp[3] = v.w;
    }
    __syncthreads();
    { const int n = tid >> 3, kq = (tid & 7) * 8; const float* tp = tile + kq * 65 + n;
      uint4 o; o.x = cvt_pk_bf16(tp[0], tp[65]); o.y = cvt_pk_bf16(tp[130], tp[195]); o.z = cvt_pk_bf16(tp[260], tp[325]); o.w = cvt_pk_bf16(tp[390], tp[455]);
      *(uint4*)(dst + (size_t)rm(n0 + n) * ldd + k0 + kq) = o; }
}
struct CvDesc { const float* src; bf16* dst; int ldn, ldd, scale, k0; };
template <int MODE>
__device__ __forceinline__ CvDesc cv_decode(const P& p, int u) {
    CvDesc d;
    if (MODE == 1) {
        if (u < 512) { const int kt = u & 15, nt = u >> 4; d.src = p.w_in + (size_t)(kt * 64) * NPROJ + nt * 128; d.ldn = NPROJ; d.dst = p.W1t + (size_t)(nt * 128) * D + kt * 64; }
        else { const int q = u - 512, kt = q & 15, nt = q >> 4; d.src = p.w_out + (size_t)(kt * 64) * D + nt * 128; d.ldn = D; d.dst = p.W2t + (size_t)(nt * 128) * D + kt * 64; }
        d.ldd = D; d.scale = 0; d.k0 = 0; return d;
    }
    if (MODE == 0) { const int e = u >> 7, v = u & 127, w = v >> 6, q = v & 63, kt = q & 15, nt = q >> 4;
        d.src = (w ? p.w_up : p.w_gate) + (size_t)e * D * DE + (size_t)(kt * 64) * DE + nt * 128; d.ldn = DE; d.k0 = kt * 64; d.scale = 1;
        d.dst = p.Wgu + ((size_t)e * 1024 + nt * 256 + w * 128) * D + kt * 64; d.ldd = D; }
    else { const int e = u >> 6, q = u & 63, kt = q & 7, nt = q >> 3;
        d.src = p.w_down + (size_t)e * DE * D + (size_t)(kt * 64) * D + nt * 128; d.ldn = D; d.k0 = kt * 64; d.scale = 0;
        d.dst = p.Wd + ((size_t)e * 1024 + nt * 128) * DE + kt * 64; d.ldd = DE; }
    return d;
}
template <int MODE>
__device__ __forceinline__ void ph_conv(const P& p, float* tile, int it0, int it1) {
    int tid_ = threadIdx.x; asm volatile("" : "+v"(tid_));
    const int tid = tid_, total = MODE == 1 ? 640 : (MODE == 0 ? NE * 128 : NE * 64);
    float4 cur[4], nxt[4];
    int u = blockIdx.x + it0 * gridDim.x;
    const int uend = (long)blockIdx.x + (long)it1 * gridDim.x < total ? blockIdx.x + it1 * gridDim.x : total;
    CvDesc dc{};
    if (u < uend) { dc = cv_decode<MODE>(p, u);
#pragma unroll
        for (int q = 0; q < 4; ++q) { const int idx = tid + 512 * q, kk = idx >> 5, nq = (idx & 31) * 4; cur[q] = *(const float4*)(dc.src + (size_t)kk * dc.ldn + nq); } }
    for (; u < uend; u += gridDim.x) {
        const int un = u + gridDim.x; CvDesc dn = dc;
        if (un < uend) { dn = cv_decode<MODE>(p, un);
#pragma unroll
            for (int q = 0; q < 4; ++q) { const int idx = tid + 512 * q, kk = idx >> 5, nq = (idx & 31) * 4; nxt[q] = *(const float4*)(dn.src + (size_t)kk * dn.ldn + nq); } }
        __syncthreads();
#pragma unroll
        for (int q = 0; q < 4; ++q) { const int idx = tid + 512 * q, kk = idx >> 5, nq = (idx & 31) * 4; const float s = dc.scale ? p.norm_ffn[dc.k0 + kk] : 1.0f;
            float* tp = tile + kk * 129 + nq; tp[0] = cur[q].x * s; tp[1] = cur[q].y * s; tp[2] = cur[q].z * s; tp[3] = cur[q].w * s; }
        __syncthreads();
        { const int n = tid >> 2, kq = (tid & 3) * 16; const float* tp = tile + kq * 129 + n;
          u32x4 o0, o1;
          o0.x = cvt_pk_bf16(tp[0], tp[129]); o0.y = cvt_pk_bf16(tp[2 * 129], tp[3 * 129]); o0.z = cvt_pk_bf16(tp[4 * 129], tp[5 * 129]); o0.w = cvt_pk_bf16(tp[6 * 129], tp[7 * 129]);
          o1.x = cvt_pk_bf16(tp[8 * 129], tp[9 * 129]); o1.y = cvt_pk_bf16(tp[10 * 129], tp[11 * 129]); o1.z = cvt_pk_bf16(tp[12 * 129], tp[13 * 129]); o1.w = cvt_pk_bf16(tp[14 * 129], tp[15 * 129]);
          bf16* dp = dc.dst + (size_t)n * dc.ldd + kq; *(u32x4*)dp = o0; *(u32x4*)(dp + 8) = o1; }
        dc = dn;
#pragma unroll
        for (int q = 0; q < 4; ++q) cur[q] = nxt[q];
    }
    __syncthreads();
}

template <int MODE>
__device__ __forceinline__ void conv_tiles(const P& p, float* tile, int u0, int n) {
    int tid_ = threadIdx.x; asm volatile("" : "+v"(tid_));
    const int tid = tid_, total = MODE == 1 ? 640 : (MODE == 0 ? NE * 128 : NE * 64);
    const int uend = u0 + n < total ? u0 + n : total;
    float4 cur[4][4];
#pragma unroll
    for (int t = 0; t < 4; ++t) if (u0 + t < uend) { const CvDesc dc = cv_decode<MODE>(p, u0 + t);
#pragma unroll
        for (int q = 0; q < 4; ++q) { const int idx = tid + 512 * q, kk = idx >> 5, nq = (idx & 31) * 4; cur[t][q] = *(const float4*)(dc.src + (size_t)kk * dc.ldn + nq); } }
#pragma unroll
    for (int t = 0; t < 4; ++t) if (u0 + t < uend) { const CvDesc dc = cv_decode<MODE>(p, u0 + t);
        __syncthreads();
#pragma unroll
        for (int q = 0; q < 4; ++q) { const int idx = tid + 512 * q, kk = idx >> 5, nq = (idx & 31) * 4; const float s = dc.scale ? p.norm_ffn[dc.k0 + kk] : 1.0f;
            float* tp = tile + kk * 129 + nq; tp[0] = cur[t][q].x * s; tp[1] = cur[t][q].y * s; tp[2] = cur[t][q].z * s; tp[3] = cur[t][q].w * s; }
        __syncthreads();
        { const int n_ = tid >> 2, kq = (tid & 3) * 16; const float* tp = tile + kq * 129 + n_;
          u32x4 o0, o1;
          o0.x = cvt_pk_bf16(tp[0], tp[129]); o0.y = cvt_pk_bf16(tp[2 * 129], tp[3 * 129]); o0.z = cvt_pk_bf16(tp[4 * 129], tp[5 * 129]); o0.w = cvt_pk_bf16(tp[6 * 129], tp[7 * 129]);
          o1.x = cvt_pk_bf16(tp[8 * 129], tp[9 * 129]); o1.y = cvt_pk_bf16(tp[10 * 129], tp[11 * 129]); o1.z = cvt_pk_bf16(tp[12 * 129], tp[13 * 129]); o1.w = cvt_pk_bf16(tp[14 * 129], tp[15 * 129]);
          bf16* dp = dc.dst + (size_t)n_ * dc.ldd + kq; *(u32x4*)dp = o0; *(u32x4*)(dp + 8) = o1; }
    }
}

struct GIn { static constexpr bool GATHER = false; const char* A; int kstepA, K; const char* Bt;
    __device__ __forceinline__ unsigned aoff(const Unit& u, int r, int C) const { const int row = u.pm * BM + (u.pn < NHY / BM ? 128 * ((r >> 6) & 1) + 8 * (r & 15) + 4 * (r >> 7) + ((r >> 4) & 3) : r); return (unsigned)row * (D * 2) + (unsigned)(C * 2); }
    __device__ __forceinline__ const char* bptr(const Unit& u) const { return Bt + (size_t)u.pn * BM * K * 2; } };
struct EpiIn { static constexpr bool PERM = true; bf16* pT; bf16* pg;
    __device__ __forceinline__ void operator()(const f32x4 (&acc)[2][2][4][2], const Unit& u, int wr, int wc, int fr, int fq) const {
        if (u.pn < NHY / BM) {
            const int xr = u.pm * BM + 128 * wr + 8 * fr, b = xr / SEQ, t = NMETA + xr % SEQ;
#pragma unroll
            for (int bj = 0; bj < 2; ++bj)
#pragma unroll
                for (int n = 0; n < 2; ++n)
#pragma unroll
                    for (int j = 0; j < 4; ++j) { const int col = u.pn * BM + bj * HALF + wc * 32 + 8 * fq + 4 * n + j;
                        u32x4 o; o.x = cvt_pk_bf16(acc[0][bj][0][n][j], acc[0][bj][1][n][j]); o.y = cvt_pk_bf16(acc[0][bj][2][n][j], acc[0][bj][3][n][j]);
                        o.z = cvt_pk_bf16(acc[1][bj][0][n][j], acc[1][bj][1][n][j]); o.w = cvt_pk_bf16(acc[1][bj][2][n][j], acc[1][bj][3][n][j]);
                        *(u32x4*)(pT + ((size_t)col * BATCH + b) * LP + t) = o; }
        } else {
#pragma unroll
            for (int ai = 0; ai < 2; ++ai)
#pragma unroll
                for (int m = 0; m < 4; ++m) { const int xr = u.pm * BM + ai * HALF + wr * 64 + m * 16 + fr; const int tok = (xr / SEQ) * L + NMETA + xr % SEQ;
#pragma unroll
                    for (int bj = 0; bj < 2; ++bj) { const f32x4 v0 = acc[ai][bj][m][0], v1 = acc[ai][bj][m][1];
                        u32x4 o; o.x = cvt_pk_bf16(v0[0], v0[1]); o.y = cvt_pk_bf16(v0[2], v0[3]); o.z = cvt_pk_bf16(v1[0], v1[1]); o.w = cvt_pk_bf16(v1[2], v1[3]);
                        *(u32x4*)(pg + blk16(tok, (u.pn * BM - NHY) + bj * HALF + wc * 32 + 8 * fq, NHG / 16)) = o; } }
        }
    } };
__device__ __forceinline__ void ph_inproj_meta(const P& p, LAS unsigned char* lds) {
    int tid_ = threadIdx.x; asm volatile("" : "+v"(tid_));
    const int tid = tid_, w = __builtin_amdgcn_readfirstlane(tid >> 6), lane = tid & 63, i = lane & 15, g = lane >> 4;
    LAS float* part = (LAS float*)lds;
    for (int ct = blockIdx.x; ct < NPROJ / 16; ct += gridDim.x) {
        __syncthreads();
        f32x4 acc = (f32x4){0.f, 0.f, 0.f, 0.f};
#pragma unroll
        for (int kk = 0; kk < 4; ++kk) {
            const int k = 128 * w + 32 * kk + 8 * g;
            const bf16x8 a = *(const bf16x8*)(p.W1t + (size_t)(16 * ct + i) * D + k), bb = *(const bf16x8*)(p.Am + (size_t)i * D + k);
            acc = __builtin_amdgcn_mfma_f32_16x16x32_bf16(a, bb, acc, 0, 0, 0);
        }
#pragma unroll
        for (int r = 0; r < 4; ++r) part[(w * 16 + 4 * g + r) * 17 + i] = acc[r];
        __syncthreads();
        float vsum = 0.f;
        if (tid < 256) {
            const int cl = tid >> 4, t = tid & 15;
#pragma unroll
            for (int ww = 0; ww < 8; ++ww) vsum += part[(ww * 16 + cl) * 17 + t];
        }
        __syncthreads();
        if (tid < 256) part[(tid >> 4) * 17 + (tid & 15)] = vsum;
        __syncthreads();
        if (tid < 256) {
            const int r = tid >> 4, b = tid & 15; u32x4 o0, o1;
            if (16 * ct < NHY) {
                const LAS float* s = part + r * 17;
                o0.x = cvt_pk_bf16(s[0], s[1]); o0.y = cvt_pk_bf16(s[2], s[3]); o0.z = cvt_pk_bf16(s[4], s[5]); o0.w = cvt_pk_bf16(s[6], s[7]);
                o1.x = cvt_pk_bf16(s[8], s[9]); o1.y = cvt_pk_bf16(s[10], s[11]); o1.z = cvt_pk_bf16(s[12], s[13]); o1.w = cvt_pk_bf16(s[14], s[15]);
                bf16* dp = p.pT + ((size_t)(16 * ct + r) * BATCH + b) * LP; *(u32x4*)dp = o0; *(u32x4*)(dp + 8) = o1;
            } else {
                float s[16];
#pragma unroll
                for (int q = 0; q < 16; ++q) s[q] = part[q * 17 + r];
                o0.x = cvt_pk_bf16(s[0], s[1]); o0.y = cvt_pk_bf16(s[2], s[3]); o0.z = cvt_pk_bf16(s[4], s[5]); o0.w = cvt_pk_bf16(s[6], s[7]);
                o1.x = cvt_pk_bf16(s[8], s[9]); o1.y = cvt_pk_bf16(s[10], s[11]); o1.z = cvt_pk_bf16(s[12], s[13]); o1.w = cvt_pk_bf16(s[14], s[15]);
                bf16* dp = p.pg + blk16(b * L + r, 16 * ct - NHY, NHG / 16); *(u32x4*)dp = o0; *(u32x4*)(dp + 8) = o1;
            }
        }
    }
    __syncthreads();
}
__device__ __forceinline__ void ph_inproj(const P& p, LAS unsigned char* lds) {
    GIn g{(const char*)p.A, BK * 2, D, (const char*)p.W1t}; StaticOrder S; S.init(NX / BM, NPROJ / BM, gridDim.x, blockIdx.x); EpiIn E{p.pT, p.pg};
    gemm_phase(lds, g, S, E);
    ph_inproj_meta(p, lds);
}
struct GOut { static constexpr bool GATHER = false; const char* A; int kstepA, K; const char* Bt;
    __device__ __forceinline__ unsigned aoff(const Unit& u, int r, int C) const { return (unsigned)(u.pm * BM + r) * (D * 2) + (unsigned)(C * 2); }
    __device__ __forceinline__ const char* bptr(const Unit& u) const { return Bt + (size_t)u.pn * BM * K * 2; } };
struct EpiOut { static constexpr bool PERM = true; const float* x; bf16* h1;
    __device__ __forceinline__ void operator()(const f32x4 (&acc)[2][2][4][2], const Unit& u, int wr, int wc, int fr, int fq) const {
#pragma unroll
        for (int ai = 0; ai < 2; ++ai)
#pragma unroll
            for (int m = 0; m < 4; ++m) { const int row = u.pm * BM + ai * HALF + wr * 64 + m * 16 + fr, col0 = u.pn * BM + wc * 32 + 8 * fq;
#pragma unroll
                for (int bj = 0; bj < 2; ++bj) { const size_t off = (size_t)row * D + col0 + bj * HALF;
                    const f32x4 v0 = *(const f32x4*)(x + off) + acc[ai][bj][m][0], v1 = *(const f32x4*)(x + off + 4) + acc[ai][bj][m][1];
                    u32x4 o; o.x = cvt_pk_bf16(v0[0], v0[1]); o.y = cvt_pk_bf16(v0[2], v0[3]); o.z = cvt_pk_bf16(v1[0], v1[1]); o.w = cvt_pk_bf16(v1[2], v1[3]);
                    *(u32x4*)(h1 + off) = o; } }
    } };
__device__ __forceinline__ void ph_outproj(const P& p, LAS unsigned char* lds) {
    GOut g{(const char*)p.A, BK * 2, D, (const char*)p.W2t}; StaticOrder S; S.init(NX / BM, D / BM, gridDim.x, blockIdx.x); EpiOut E{p.x, p.h1};
    gemm_phase(lds, g, S, E);
}

constexpr int ZS = 2088, ZSB = ZS * 2;
constexpr int HY_ZB = 0, HY_Z1 = 16 * ZSB, HY_G0 = 2 * 16 * ZSB, HY_G1 = HY_G0 + GL * 2 + 64  , HY_END = HY_G1 + GL * 2;
typedef short bf16x8a __attribute__((ext_vector_type(8), aligned(4)));

__device__ __forceinline__ float bflo(unsigned u) { return __uint_as_float(u << 16); }
__device__ __forceinline__ float bfhi(unsigned u) { return __uint_as_float(u & 0xffff0000u); }

__device__ __forceinline__ void hy_load_conv(const P& p, int col, LAS unsigned char* dst) {
    int tidx = threadIdx.x; asm volatile("" : "+v"(tidx));
    const float w0 = p.conv_w[col], w1 = p.conv_w[NHY + col], w2 = p.conv_w[2 * NHY + col], bb = p.conv_b[col];
    u32x4 v[9]; unsigned short hm[9], hp[9];
#pragma unroll
    for (int it = 0; it < 9; ++it) {
        const int gi = tidx + 512 * it, b = gi / (ZS / 8), t0 = (gi % (ZS / 8)) * 8;
        v[it] = (u32x4){0u, 0u, 0u, 0u}; hm[it] = 0; hp[it] = 0;
        if (gi < 16 * (ZS / 8) && t0 < L) {
            const bf16* src = p.pT + ((size_t)col * BATCH + b) * LP + t0;
            v[it] = *(const u32x4*)src;
            if (t0 > 0) hm[it] = src[-1];
            if (t0 + 8 < L) hp[it] = src[8];
        }
    }
#pragma unroll
    for (int it = 0; it < 9; ++it) {
        const int gi = tidx + 512 * it, b = gi / (ZS / 8), t0 = (gi % (ZS / 8)) * 8;
        if (gi < 16 * (ZS / 8)) {
            u32x4 o = (u32x4){0u, 0u, 0u, 0u};
            if (t0 < L) {
                float f[10];
                f[0] = bf2f(hm[it]); f[9] = bf2f(hp[it]);
                f[1] = bflo(v[it].x); f[2] = bfhi(v[it].x); f[3] = bflo(v[it].y); f[4] = bfhi(v[it].y); f[5] = bflo(v[it].z); f[6] = bfhi(v[it].z); f[7] = bflo(v[it].w); f[8] = bfhi(v[it].w);
                float u[8];
#pragma unroll
                for (int j = 0; j < 8; ++j) u[j] = bb + w0 * f[j] + w1 * f[j + 1] + w2 * f[j + 2];
                o.x = cvt_pk_bf16(u[0], u[1]); o.y = cvt_pk_bf16(u[2], u[3]); o.z = cvt_pk_bf16(u[4], u[5]); o.w = cvt_pk_bf16(u[6], u[7]);
            }
            *(LAS u32x4*)(dst + b * ZSB + t0 * 2) = o;
        }
    }
}
__device__ __forceinline__ void hy_dma_raw(const P& p, int col, LAS unsigned char* dst) {
    int tidx = threadIdx.x; asm volatile("" : "+v"(tidx));
    const int w = __builtin_amdgcn_readfirstlane(tidx >> 6), lane = tidx & 63;
#pragma unroll
    for (int it = 0; it < 9; ++it) {
        const int g0 = __builtin_amdgcn_readfirstlane(512 * it + 64 * w), gi = g0 + lane, b = gi / (ZS / 8), t0 = (gi % (ZS / 8)) * 8;
        if (gi < 16 * (ZS / 8) && t0 < L)
            __builtin_amdgcn_global_load_lds((const unsigned*)(p.pT + ((size_t)col * BATCH + b) * LP + t0), (LAS unsigned*)(dst + g0 * 16), 16, 0, 0);
    }
}
__device__ __forceinline__ void hy_conv_inplace(const P& p, int col, LAS unsigned char* img) {
    int tidx = threadIdx.x; asm volatile("" : "+v"(tidx));
    const float w0 = p.conv_w[col], w1 = p.conv_w[NHY + col], w2 = p.conv_w[2 * NHY + col], bb = p.conv_b[col];
    asm volatile("s_waitcnt vmcnt(0)" ::: "memory");
    __syncthreads();
    u32x4 v[9]; unsigned hh[9];
#pragma unroll
    for (int it = 0; it < 9; ++it) {
        const int gi = tidx + 512 * it, t0 = (gi % (ZS / 8)) * 8;
        v[it] = (u32x4){0u, 0u, 0u, 0u}; hh[it] = 0u;
        if (gi < 16 * (ZS / 8) && t0 < L) {
            const LAS unsigned char* src = img + gi * 16;
            v[it] = *(const LAS u32x4*)src;
            unsigned lo_ = 0u, hi_ = 0u;
            if (t0 > 0) lo_ = *(const LAS bf16*)(src - 2);
            if (t0 + 8 < L) hi_ = *(const LAS bf16*)(src + 16);
            hh[it] = lo_ | (hi_ << 16);
        }
    }
    __syncthreads();
#pragma unroll
    for (int it = 0; it < 9; ++it) {
        const int gi = tidx + 512 * it, t0 = (gi % (ZS / 8)) * 8;
        if (gi < 16 * (ZS / 8)) {
            u32x4 o = (u32x4){0u, 0u, 0u, 0u};
            if (t0 < L) {
                float f[10];
                f[0] = bflo(hh[it]); f[9] = bfhi(hh[it]);
                f[1] = bflo(v[it].x); f[2] = bfhi(v[it].x); f[3] = bflo(v[it].y); f[4] = bfhi(v[it].y); f[5] = bflo(v[it].z); f[6] = bfhi(v[it].z); f[7] = bflo(v[it].w); f[8] = bfhi(v[it].w);
                float u[8];
#pragma unroll
                for (int j = 0; j < 8; ++j) u[j] = bb + w0 * f[j] + w1 * f[j + 1] + w2 * f[j + 2];
                o.x = cvt_pk_bf16(u[0], u[1]); o.y = cvt_pk_bf16(u[2], u[3]); o.z = cvt_pk_bf16(u[4], u[5]); o.w = cvt_pk_bf16(u[6], u[7]);
            }
            *(LAS u32x4*)(img + gi * 16) = o;
        }
    }
    __syncthreads();
}
__device__ __forceinline__ void hy_load_taps(const P& p, int order, int c, LAS unsigned char* lds) {
    int tidx = threadIdx.x; asm volatile("" : "+v"(tidx));
    const bf16* src = p.G + ((size_t)order * 512 + c) * GL;
    for (int k = tidx; k < GL / 8; k += blockDim.x) {
        const u32x4 v = *(const u32x4*)(src + k * 8);
        const unsigned nx = (k * 8 + 8 < GL) ? (unsigned)src[k * 8 + 8] : 0u;
        *(LAS u32x4*)(lds + HY_G0 + k * 16) = v;
        u32x4 s; s.x = (v.x >> 16) | (v.y << 16); s.y = (v.y >> 16) | (v.z << 16); s.z = (v.z >> 16) | (v.w << 16); s.w = (v.w >> 16) | (nx << 16);
        *(LAS u32x4*)(lds + HY_G1 + k * 16) = s;
    }
}
template <int STAGE, class Hook>
__device__ __forceinline__ void hy_stage(const P& p, LAS unsigned char* lds, int c, float skip, Hook hook) {
    int tid_ = threadIdx.x; asm volatile("" : "+v"(tid_));
    const int tid = tid_, w = __builtin_amdgcn_readfirstlane(tid >> 6), lane = tid & 63, i = lane & 15, g = lane >> 4;
    const int it0 = w * 17;
    const LAS unsigned char* zsrc = lds + (STAGE == 0 ? HY_ZB : HY_Z1) + i * ZSB + g * 16;
    const LAS unsigned char* gl0 = ((i & 1) ? lds + HY_G0 + 2 * (8 * g - i + L - 1) : lds + HY_G1 + 2 * (8 * g - i + L - 2)) - 32 * it0;
    f32x4 acc[17];
#pragma unroll
    for (int a = 0; a < 17; ++a) acc[a] = (f32x4){0.f, 0.f, 0.f, 0.f};
    bf16x8 R[20];
#pragma unroll
    for (int a = 0; a < 17; ++a) R[a] = *(const LAS bf16x8a*)(gl0 - 32 * a);
    bf16x8 Zc = *(const LAS bf16x8*)zsrc, Zn = Zc;
    const bool full = (w != 7);
#define HY_STEP(u, js, PF) do { \
        if (PF) { R[(40 - 2 * ((u) + 1)) % 20] = *(const LAS bf16x8a*)(gl0 + 64 * ((js) + 1)); R[(41 - 2 * ((u) + 1)) % 20] = *(const LAS bf16x8a*)(gl0 + 64 * ((js) + 1) - 32); \
                  Zn = *(const LAS bf16x8*)(zsrc + 64 * ((js) + 1)); } \
        _Pragma("unroll") for (int a = 0; a < 10; ++a) acc[a] = __builtin_amdgcn_mfma_f32_16x16x32_bf16(R[(a + 40 - 2 * (u)) % 20], Zc, acc[a], 0, 0, 0); \
        if (full) { _Pragma("unroll") for (int a = 10; a < 17; ++a) acc[a] = __builtin_amdgcn_mfma_f32_16x16x32_bf16(R[(a + 40 - 2 * (u)) % 20], Zc, acc[a], 0, 0, 0); } \
        Zc = Zn; } while (0)
    for (int jb = 0; jb < 60; jb += 10) {
#pragma unroll
        for (int u = 0; u < 10; ++u) HY_STEP(u, jb + u, true);
    }
#pragma unroll
    for (int u = 0; u < 5; ++u) HY_STEP(u, 60 + u, u < 4);
#undef HY_STEP
    hook();
#pragma unroll
    for (int a = 0; a < 17; ++a) {
        const int it = it0 + a;
        if (it < 129) {
            const int t = 16 * it + 4 * g, ad = i * ZSB + t * 2;
            const u32x2 zv = *(const LAS u32x2*)(lds + HY_ZB + ad), z1v = *(const LAS u32x2*)(lds + HY_Z1 + ad);
            if (STAGE == 0) {
                u32x2 o;
                o.x = cvt_pk_bf16(bflo(z1v.x) * (acc[a][0] + skip * bflo(zv.x)), bfhi(z1v.x) * (acc[a][1] + skip * bfhi(zv.x)));
                o.y = cvt_pk_bf16(bflo(z1v.y) * (acc[a][2] + skip * bflo(zv.y)), bfhi(z1v.y) * (acc[a][3] + skip * bfhi(zv.y)));
                *(LAS u32x2*)(lds + HY_Z1 + ad) = o;
            } else {
                u32x2 o;
                o.x = cvt_pk_bf16(bflo(zv.x) * (acc[a][0] + skip * bflo(z1v.x)), bfhi(zv.x) * (acc[a][1] + skip * bfhi(z1v.x)));
                o.y = cvt_pk_bf16(bflo(zv.y) * (acc[a][2] + skip * bflo(z1v.y)), bfhi(zv.y) * (acc[a][3] + skip * bfhi(z1v.y)));
                *(u32x2*)(p.z2 + ((size_t)c * BATCH + i) * LP + t) = o;
            }
        }
    }
}
__device__ __forceinline__ void hyena_channel(const P& p, LAS unsigned char* lds, int c) {
    {
        __syncthreads();
        hy_load_conv(p, c, lds + HY_ZB); hy_load_taps(p, 0, c, lds);
        __syncthreads();
        hy_dma_raw(p, DH + c, lds + HY_Z1);
        hy_stage<0>(p, lds, c, p.fskip[c], [&]() { hy_conv_inplace(p, DH + c, lds + HY_Z1); });
        __syncthreads();
        hy_load_taps(p, 1, c, lds);
        hy_dma_raw(p, 2 * DH + c, lds + HY_ZB);
        __syncthreads();
        hy_stage<1>(p, lds, c, p.fskip[DH + c], [&]() { hy_conv_inplace(p, 2 * DH + c, lds + HY_ZB); });
    }
}

constexpr int HG_RS = 256, HG_RS64 = 128;
__device__ __forceinline__ int sw256(int row, int cb) { return row * 256 + (cb ^ ((row & 15) << 4)); }
__device__ __forceinline__ int sw128(int row, int cb) { return row * 128 + (cb ^ (((row >> 1) & 7) << 4)); }
constexpr int HG_QS = 0, HG_KS = HG_QS + 64 * HG_RS, HG_KDT = HG_KS + 64 * HG_RS, HG_VT = HG_KDT + 128 * HG_RS64, HG_SC = HG_VT + 128 * HG_RS64, HG_ST = HG_SC + 64 * HG_RS64,
              HG_DEC = HG_ST + 128 * HG_RS, HG_EBM = HG_DEC + 128 * 4, HG_END = HG_EBM + 128 * 4;
__device__ __forceinline__ float dpp_add_(float v, const int ctrl_sel) {
    int t;
    const int iv = __float_as_int(v);
    if (ctrl_sel == 0) t = __builtin_amdgcn_update_dpp(0, iv, 0x111, 0xf, 0xf, false);
    else if (ctrl_sel == 1) t = __builtin_amdgcn_update_dpp(0, iv, 0x112, 0xf, 0xf, false);
    else if (ctrl_sel == 2) t = __builtin_amdgcn_update_dpp(0, iv, 0x114, 0xf, 0xf, false);
    else if (ctrl_sel == 3) t = __builtin_amdgcn_update_dpp(0, iv, 0x118, 0xf, 0xf, false);
    else if (ctrl_sel == 4) t = __builtin_amdgcn_update_dpp(0, iv, 0x142, 0xa, 0xf, false);
    else t = __builtin_amdgcn_update_dpp(0, iv, 0x143, 0xc, 0xf, false);
    return v + __int_as_float(t);
}
__device__ __forceinline__ float wave_incl_scan(float v) { v = dpp_add_(v, 0); v = dpp_add_(v, 1); v = dpp_add_(v, 2); v = dpp_add_(v, 3); v = dpp_add_(v, 4); v = dpp_add_(v, 5); return v; }
__device__ __forceinline__ float dpp_mul_(float v, const int ctrl_sel) {
    int t; const int iv = __float_as_int(v), one = 0x3f800000;
    if (ctrl_sel == 0) t = __builtin_amdgcn_update_dpp(one, iv, 0x111, 0xf, 0xf, false);
    else if (ctrl_sel == 1) t = __builtin_amdgcn_update_dpp(one, iv, 0x112, 0xf, 0xf, false);
    else if (ctrl_sel == 2) t = __builtin_amdgcn_update_dpp(one, iv, 0x114, 0xf, 0xf, false);
    else if (ctrl_sel == 3) t = __builtin_amdgcn_update_dpp(one, iv, 0x118, 0xf, 0xf, false);
    else if (ctrl_sel == 4) t = __builtin_amdgcn_update_dpp(one, iv, 0x142, 0xa, 0xf, false);
    else t = __builtin_amdgcn_update_dpp(one, iv, 0x143, 0xc, 0xf, false);
    return v * __int_as_float(t);
}
__device__ __forceinline__ float wave_incl_prod(float v) {
    asm("s_nop 1\n\tv_mul_f32_dpp %0, %0, %0 row_shr:1 row_mask:0xf bank_mask:0xf\n\t"
        "s_nop 1\n\tv_mul_f32_dpp %0, %0, %0 row_shr:2 row_mask:0xf bank_mask:0xf\n\t"
        "s_nop 1\n\tv_mul_f32_dpp %0, %0, %0 row_shr:4 row_mask:0xf bank_mask:0xf\n\t"
        "s_nop 1\n\tv_mul_f32_dpp %0, %0, %0 row_shr:8 row_mask:0xf bank_mask:0xf\n\t"
        "s_nop 1\n\tv_mul_f32_dpp %0, %0, %0 row_bcast:15 row_mask:0xa bank_mask:0xf\n\t"
        "s_nop 1\n\tv_mul_f32_dpp %0, %0, %0 row_bcast:31 row_mask:0xc bank_mask:0xf\n\t"
        "s_nop 1" : "+v"(v));
    return v; }
__device__ __forceinline__ float rdlane(float v, int l) { return __int_as_float(__builtin_amdgcn_readlane(__float_as_int(v), l)); }

__device__ __forceinline__ void hgrn_unit(const P& p, LAS unsigned char* lds, int u) {
    int tid_ = threadIdx.x; asm volatile("" : "+v"(tid_));
    const int tid = tid_, w = __builtin_amdgcn_readfirstlane(tid >> 6), lane = tid & 63, i = lane & 15, g = lane >> 4;
    {
        const int dir = u & 1, h = (u >> 1) & 3, b = u >> 3;
        float lbv[16];
#pragma unroll
        for (int dd = 0; dd < 16; ++dd) { const float* lbp = dir ? p.lb_b : p.lb_f; const float a0 = lbp[h * 128 + 16 * w + dd], a1 = lbp[DG + h * 128 + 16 * w + dd], mx = fmaxf(a0, a1);
            const float e0 = __expf(a0 - mx), e1 = __expf(a1 - mx); lbv[dd] = e0 / (e0 + e1); }
        const int tokb = b * L;
        const int qoff = h * 128 + 16 * w, foff = (dir ? 1024 : 512) + h * 128 + 16 * w, voff = 1536 + h * 128 + 16 * w;
        bf16* po = p.o + ((size_t)dir * NTOK + (size_t)b * L) * DG + h * 128;
        f32x4 S[8];
#pragma unroll
        for (int vi = 0; vi < 8; ++vi) S[vi] = (f32x4){0.f, 0.f, 0.f, 0.f};
        __syncthreads();
        u32x4 rq0, rq1, rf0, rf1, rv0, rv1;
#define HG_TOK(m, j) (dir ? 64 * (m) + 15 - (j) : 64 * (m) - 48 + (j))
#define HG_LOADRAW(m) do { const int t_ = HG_TOK(m, lane); rq0 = rq1 = rf0 = rf1 = rv0 = rv1 = (u32x4){0u, 0u, 0u, 0u}; \
            if (t_ >= 0) { const bf16* r_ = p.pg + blk16(tokb + t_, 0, NHG / 16); rq0 = *(const u32x4*)(r_ + (qoff >> 4) * 256); rq1 = *(const u32x4*)(r_ + (qoff >> 4) * 256 + 8); \
                           rf0 = *(const u32x4*)(r_ + (foff >> 4) * 256); rf1 = *(const u32x4*)(r_ + (foff >> 4) * 256 + 8); rv0 = *(const u32x4*)(r_ + (voff >> 4) * 256); rv1 = *(const u32x4*)(r_ + (voff >> 4) * 256 + 8); } } while (0)
        HG_LOADRAW(dir ? 32 : 0);
        for (int n = 0; n < 33; ++n) {
            const int m = dir ? 32 - n : n;
            {
                const bool valid = HG_TOK(m, lane) >= 0;
                const unsigned qw[8] = {rq0.x, rq0.y, rq0.z, rq0.w, rq1.x, rq1.y, rq1.z, rq1.w}, fw[8] = {rf0.x, rf0.y, rf0.z, rf0.w, rf1.x, rf1.y, rf1.z, rf1.w};
                float qsv[16], ksv[16]; float decv = 0.f;
#pragma unroll
                for (int dd = 0; dd < 16; ++dd) {
                    const float qr = (dd & 1) ? bfhi(qw[dd >> 1]) : bflo(qw[dd >> 1]), fr_ = (dd & 1) ? bfhi(fw[dd >> 1]) : bflo(fw[dd >> 1]);
                    const float qq = qr * __builtin_amdgcn_rcpf(1.0f + __builtin_amdgcn_exp2f(-1.44269504f * qr)), fl = __builtin_amdgcn_rcpf(1.0f + __builtin_amdgcn_exp2f(-1.44269504f * fr_));
                    const float f = valid ? lbv[dd] + (1.0f - lbv[dd]) * fl : 1.0f, k = 1.0f - f;
                    const float Pj = wave_incl_prod(f), P63 = rdlane(Pj, 63);
                    qsv[dd] = qq * Pj; ksv[dd] = k * __builtin_amdgcn_rcpf(Pj);
                    *(LAS bf16*)(lds + HG_KDT + sw128(16 * w + dd, lane * 2)) = f2bf(ksv[dd] * P63);
                    decv = (lane == dd) ? P63 : decv;
                }
                u32x4 o0, o1;
#define HG_PK(arr, dst) o0.x = cvt_pk_bf16(arr[0], arr[1]); o0.y = cvt_pk_bf16(arr[2], arr[3]); o0.z = cvt_pk_bf16(arr[4], arr[5]); o0.w = cvt_pk_bf16(arr[6], arr[7]); \
                        o1.x = cvt_pk_bf16(arr[8], arr[9]); o1.y = cvt_pk_bf16(arr[10], arr[11]); o1.z = cvt_pk_bf16(arr[12], arr[13]); o1.w = cvt_pk_bf16(arr[14], arr[15]); \
                        *(LAS u32x4*)(lds + (dst) + sw256(lane, 32 * w)) = o0; *(LAS u32x4*)(lds + (dst) + sw256(lane, 32 * w + 16)) = o1;
                HG_PK(qsv, HG_QS) HG_PK(ksv, HG_KS)
#undef HG_PK
                if (lane < 16) *(LAS float*)(lds + HG_DEC + (16 * w + lane) * 4) = decv;
                const unsigned vw[8] = {rv0.x, rv0.y, rv0.z, rv0.w, rv1.x, rv1.y, rv1.z, rv1.w};
#pragma unroll
                for (int e = 0; e < 16; ++e) *(LAS bf16*)(lds + HG_VT + sw128(16 * w + e, lane * 2)) = (bf16)((e & 1) ? (vw[e >> 1] >> 16) : (vw[e >> 1] & 0xffffu));
            }
            if (n + 1 < 33) { const int mn = dir ? 31 - n : n + 1; HG_LOADRAW(mn); }
            __syncthreads();
            {
#pragma unroll
                for (int vi = 0; vi < 8; ++vi) { const f32x4 sv = S[vi]; u32x2 o; o.x = cvt_pk_bf16(sv[0], sv[1]); o.y = cvt_pk_bf16(sv[2], sv[3]); *(LAS u32x2*)(lds + HG_ST + sw256(16 * vi + i, (16 * w + 4 * g) * 2)) = o; }
            }
            {
                const int si = w >> 1, tp = (w & 1) * 2;
                f32x4 sa[2] = {(f32x4){0.f, 0.f, 0.f, 0.f}, (f32x4){0.f, 0.f, 0.f, 0.f}};
#pragma unroll
                for (int kk = 0; kk < 4; ++kk) {
                    const bf16x8 A = *(const LAS bf16x8*)(lds + HG_KS + sw256(16 * si + i, (32 * kk + 8 * g) * 2));
#pragma unroll
                    for (int q = 0; q < 2; ++q) { const bf16x8 B = *(const LAS bf16x8*)(lds + HG_QS + sw256(16 * (tp + q) + i, (32 * kk + 8 * g) * 2)); sa[q] = __builtin_amdgcn_mfma_f32_16x16x32_bf16(A, B, sa[q], 0, 0, 0); }
                }
#pragma unroll
                for (int q = 0; q < 2; ++q) {
                    const int t = 16 * (tp + q) + i, s0 = 16 * si + 4 * g;
                    u32x2 o; o.x = cvt_pk_bf16(s0 <= t ? sa[q][0] : 0.f, s0 + 1 <= t ? sa[q][1] : 0.f); o.y = cvt_pk_bf16(s0 + 2 <= t ? sa[q][2] : 0.f, s0 + 3 <= t ? sa[q][3] : 0.f);
                    *(LAS u32x2*)(lds + HG_SC + sw128(t, s0 * 2)) = o;
                }
            }
            __syncthreads();
            {
                f32x4 oa[4];
#pragma unroll
                for (int q = 0; q < 4; ++q) oa[q] = (f32x4){0.f, 0.f, 0.f, 0.f};
#pragma unroll
                for (int kk = 0; kk < 2; ++kk) {
                    const bf16x8 A = *(const LAS bf16x8*)(lds + HG_VT + sw128(16 * w + i, (32 * kk + 8 * g) * 2));
#pragma unroll
                    for (int q = 0; q < 4; ++q) { const bf16x8 B = *(const LAS bf16x8*)(lds + HG_SC + sw128(16 * q + i, (32 * kk + 8 * g) * 2)); oa[q] = __builtin_amdgcn_mfma_f32_16x16x32_bf16(A, B, oa[q], 0, 0, 0); }
                }
#pragma unroll
                for (int kk = 0; kk < 4; ++kk) {
                    const bf16x8 A = *(const LAS bf16x8*)(lds + HG_ST + sw256(16 * w + i, (32 * kk + 8 * g) * 2));
#pragma unroll
                    for (int q = 0; q < 4; ++q) { const bf16x8 B = *(const LAS bf16x8*)(lds + HG_QS + sw256(16 * q + i, (32 * kk + 8 * g) * 2)); oa[q] = __builtin_amdgcn_mfma_f32_16x16x32_bf16(A, B, oa[q], 0, 0, 0); }
                }
#pragma unroll
                for (int q = 0; q < 4; ++q) {
                    const int t = HG_TOK(m, 16 * q + i);
                    if (t >= 0) { u32x2 o; o.x = cvt_pk_bf16(oa[q][0], oa[q][1]); o.y = cvt_pk_bf16(oa[q][2], oa[q][3]); *(u32x2*)(po + (size_t)t * DG + 16 * w + 4 * g) = o; }
                }
            }
            {
                const f32x4 dv = *(const LAS f32x4*)(lds + HG_DEC + (16 * w + 4 * g) * 4);
#pragma unroll
                for (int vi = 0; vi < 8; ++vi) S[vi] = S[vi] * dv;
#pragma unroll
                for (int kk = 0; kk < 2; ++kk) {
                    const bf16x8 A = *(const LAS bf16x8*)(lds + HG_KDT + sw128(16 * w + i, (32 * kk + 8 * g) * 2));
#pragma unroll
                    for (int vi = 0; vi < 8; ++vi) { const bf16x8 B = *(const LAS bf16x8*)(lds + HG_VT + sw128(16 * vi + i, (32 * kk + 8 * g) * 2)); S[vi] = __builtin_amdgcn_mfma_f32_16x16x32_bf16(A, B, S[vi], 0, 0, 0); }
                }
            }
            __syncthreads();
        }
#undef HG_TOK
#undef HG_LOADRAW
    }
}
__device__ __forceinline__ void ph_mixers(const P& p, LAS unsigned char* lds, LAS int* ticket) {
    if ((blockIdx.x & 1) == 0) for (int u = blockIdx.x >> 1; u < BATCH * 8; u += (gridDim.x + 1) >> 1) hgrn_unit(p, lds, u);
    for (;;) {
        __syncthreads();
        if (threadIdx.x == 0) *ticket = (int)atomicAdd(p.cnt + 64, 1u);
        __syncthreads();
        const int c = *ticket;
        if (c >= DH) {
            const int u0 = 4 * (int)gridDim.x + 4 * (c - DH); if (u0 >= NE * 64) break;
            conv_tiles<2>(p, (float*)(void*)lds, u0, 4); continue; }
        hyena_channel(p, lds, c);
    }
    __syncthreads();
}

__device__ __forceinline__ void ph_filters(const P& p, float* sm) {
    float* z = sm; float* h1 = sm + 8 * 33; float* h2 = h1 + 8 * 64;
    float* W1 = sm + 1296; float* B1 = W1 + 33 * 64; float* W2 = B1 + 64; float* B2 = W2 + 64 * 64; float* FQ = B2 + 64;
    int tid_ = threadIdx.x; asm volatile("" : "+v"(tid_));
    const int tid = tid_;
    __syncthreads();
    { float4 a1[2], a2[2];
#pragma unroll
      for (int j = 0; j < 2; ++j) { const int x = tid + 512 * j; a1[j] = x < 33 * 16 ? ((const float4*)p.fw1)[x] : make_float4(0.f, 0.f, 0.f, 0.f); a2[j] = ((const float4*)p.fw2)[x]; }
#pragma unroll
      for (int j = 0; j < 2; ++j) { const int x = tid + 512 * j; if (x < 33 * 16) ((float4*)W1)[x] = a1[j]; ((float4*)W2)[x] = a2[j]; } }
    if (tid < 64) { B1[tid] = p.fb1[tid]; B2[tid] = p.fb2[tid]; FQ[tid] = p.ffreq[tid]; }
    for (int un = (blockIdx.x + (gridDim.x >> 1)) % gridDim.x; un < (L / 8) * 4; un += gridDim.x) {
        const int grp = un >> 2, nq = un & 3, j0 = grp * 8, n = nq * 512 + tid;
        float wv[64];
#pragma unroll
        for (int q = 0; q < 64; ++q) wv[q] = p.fw3[q * 2048 + n];
        __syncthreads();
        if (tid < 8 * 33) {
            const int lg = tid / 33, ft = tid % 33, j = j0 + lg; float v;
            if (ft == 0) v = (float)((double)j * (1.0 / (double)(L - 1)));
            else { const int ib = (ft - 1) & 15; const double band = 1e-4 + (double)ib * ((double)(15) - 1e-4) / 15.0; double turns = (double)j * band * (1.0 / (double)L); turns -= floor(turns);
                   const float ang = 6.28318530717958647692f * (float)turns;
                   v = ft <= 16 ? cosf(ang) : -sinf(ang); }
            z[tid] = v;
        }
        __syncthreads();
        { const int lg = tid >> 6, hc = tid & 63; float a = B1[hc];
#pragma unroll
          for (int q = 0; q < 33; ++q) a += z[lg * 33 + q] * W1[q * 64 + hc];
          h1[tid] = sinf(FQ[hc] * a); }
        __syncthreads();
        { const int lg = tid >> 6, hc = tid & 63; float a = B2[hc];
#pragma unroll 16
          for (int q = 0; q < 64; ++q) a += h1[lg * 64 + q] * W2[q * 64 + hc];
          h2[tid] = sinf(FQ[hc] * a); }
        __syncthreads();
        {
            float acc[8];
#pragma unroll
            for (int lg = 0; lg < 8; ++lg) acc[lg] = 0.f;
#pragma unroll
            for (int q4 = 0; q4 < 16; ++q4) {
#pragma unroll
                for (int lg = 0; lg < 8; ++lg) { const float4 hv = *(const float4*)(h2 + lg * 64 + 4 * q4); acc[lg] += (hv.x * wv[4 * q4] + hv.y * wv[4 * q4 + 1]) + (hv.z * wv[4 * q4 + 2] + hv.w * wv[4 * q4 + 3]); } }
            const int dir = n >> 10, order = (n >> 9) & 1, c = n & 511;
            const float lo = -3.0701134573f  , hi = -15.3505672866f  ;
            const float delta = fabsf(lo + (hi - lo) * (float)c * (1.0f / 511.0f));
            bf16* gp = p.G + ((size_t)order * 512 + c) * GL;
            bf16 ov[8];
#pragma unroll
            for (int lg = 0; lg < 8; ++lg) ov[lg] = f2bf(acc[lg] * __expf(-z[lg * 33] * delta));
            if (dir == 0) {
                u32x4 o; o.x = (unsigned)ov[7] | ((unsigned)ov[6] << 16); o.y = (unsigned)ov[5] | ((unsigned)ov[4] << 16); o.z = (unsigned)ov[3] | ((unsigned)ov[2] << 16); o.w = (unsigned)ov[1] | ((unsigned)ov[0] << 16);
                *(u32x4*)(gp + (L - 8 - j0)) = o;
            } else {
#pragma unroll
                for (int lg = 0; lg < 8; ++lg) if (j0 + lg >= 1) gp[L - 1 + j0 + lg] = ov[lg];
            }
        }
    }
    for (int x = blockIdx.x * blockDim.x + tid; x < 1024 * (GL - (2 * L - 1)); x += gridDim.x * blockDim.x) {
        const int row = x / (GL - (2 * L - 1)), m = (2 * L - 1) + x % (GL - (2 * L - 1));
        p.G[(size_t)row * GL + m] = 0;
    }
    __syncthreads();
}

constexpr int BA_RS = 1040;
__device__ __forceinline__ void ph_buildA2(const P& p, LAS unsigned char* lds) {
    int tid_ = threadIdx.x; asm volatile("" : "+v"(tid_));
    const int tid = tid_, w = __builtin_amdgcn_readfirstlane(tid >> 6), lane = tid & 63;
    float hyn[8], hgn[8];
#pragma unroll
    for (int e = 0; e < 8; ++e) { hyn[e] = p.hy_norm[8 * lane + e]; hgn[e] = p.hg_norm[8 * lane + e]; }
    for (int u = blockIdx.x; u < BATCH * (SEQ / 128); u += gridDim.x) {
        const int b = u / (SEQ / 128), tt = u % (SEQ / 128), t0 = NMETA + 128 * tt;
        __syncthreads();
        {
            const bf16* src = p.z2 + ((size_t)tid * BATCH + b) * LP + t0;
            u32x4 v[16];
#pragma unroll
            for (int q = 0; q < 16; ++q) v[q] = *(const u32x4*)(src + 8 * q);
#pragma unroll
            for (int q = 0; q < 16; ++q) {
                const unsigned wv[4] = {v[q].x, v[q].y, v[q].z, v[q].w};
#pragma unroll
                for (int e = 0; e < 8; ++e) *(LAS bf16*)(lds + (8 * q + e) * BA_RS + tid * 2) = (bf16)((e & 1) ? (wv[e >> 1] >> 16) : (wv[e >> 1] & 0xffffu));
            }
        }
        __syncthreads();
#pragma unroll 2
        for (int jt = 16 * w; jt < 16 * w + 16; ++jt) {
            const size_t tok = (size_t)b * L + t0 + jt; bf16* dst = p.A + ((size_t)b * SEQ + 128 * tt + jt) * D;
            const u32x4 zv = *(const LAS u32x4*)(lds + jt * BA_RS + lane * 16);
            const u32x4 of = *(const u32x4*)(p.o + tok * DG + 8 * lane), ob = *(const u32x4*)(p.o + ((size_t)NTOK + tok) * DG + 8 * lane), gv = *(const u32x4*)(p.pg + blk16((int)tok, 2048 + 8 * lane, NHG / 16));
            float z[8] = {bflo(zv.x), bfhi(zv.x), bflo(zv.y), bfhi(zv.y), bflo(zv.z), bfhi(zv.z), bflo(zv.w), bfhi(zv.w)};
            float ss = 0.f;
#pragma unroll
            for (int e = 0; e < 8; ++e) ss += z[e] * z[e];
            ss = wave_sum(ss);
            const float r = rsqrtf(ss * (1.0f / DH) + EPS);
            u32x4 o; o.x = cvt_pk_bf16(z[0] * r * hyn[0], z[1] * r * hyn[1]); o.y = cvt_pk_bf16(z[2] * r * hyn[2], z[3] * r * hyn[3]);
            o.z = cvt_pk_bf16(z[4] * r * hyn[4], z[5] * r * hyn[5]); o.w = cvt_pk_bf16(z[6] * r * hyn[6], z[7] * r * hyn[7]);
            *(u32x4*)(dst + 8 * lane) = o;
            float ov[8] = {bflo(of.x) + bflo(ob.x), bfhi(of.x) + bfhi(ob.x), bflo(of.y) + bflo(ob.y), bfhi(of.y) + bfhi(ob.y), bflo(of.z) + bflo(ob.z), bfhi(of.z) + bfhi(ob.z), bflo(of.w) + bflo(ob.w), bfhi(of.w) + bfhi(ob.w)};
            const float gg[8] = {bflo(gv.x), bfhi(gv.x), bflo(gv.y), bfhi(gv.y), bflo(gv.z), bfhi(gv.z), bflo(gv.w), bfhi(gv.w)};
            float hs = 0.f;
#pragma unroll
            for (int e = 0; e < 8; ++e) hs += ov[e] * ov[e];
            hs += __shfl_xor(hs, 1); hs += __shfl_xor(hs, 2); hs += __shfl_xor(hs, 4); hs += __shfl_xor(hs, 8);
            const float hr = rsqrtf(hs * (1.0f / 128.0f) + EPS);
            float y[8];
#pragma unroll
            for (int e = 0; e < 8; ++e) y[e] = ov[e] * hr * hgn[e] * siluf_(gg[e]);
            u32x4 o2; o2.x = cvt_pk_bf16(y[0], y[1]); o2.y = cvt_pk_bf16(y[2], y[3]); o2.z = cvt_pk_bf16(y[4], y[5]); o2.w = cvt_pk_bf16(y[6], y[7]);
            *(u32x4*)(dst + DH + 8 * lane) = o2;
        }
    }
    __syncthreads();
}

__device__ __forceinline__ void ph_conv_router(const P& p) {
    for (int idx = blockIdx.x * blockDim.x + threadIdx.x; idx < 80 * 1024; idx += gridDim.x * blockDim.x) {
        const int n = idx >> 10, k = idx & 1023;
        const float wv = (n < 8 ? p.w_rg[k * 8 + n] : (n < 72 ? p.w_re[k * 64 + (n - 8)] : 0.f)) * p.norm_ffn[k];
        const bf16 hi = f2bf(wv); p.Wr[idx] = hi; p.Wr[80 * 1024 + idx] = f2bf(wv - bf2f(hi));
    }
}
template <bool DRY>
__device__ __forceinline__ void ph_router(const P& p, LAS unsigned char* lds) {
    int tid_ = threadIdx.x; asm volatile("" : "+v"(tid_));
    const int tid = tid_, w = __builtin_amdgcn_readfirstlane(tid >> 6), lane = tid & 63, i = lane & 15, g = lane >> 4;
    LAS float* lg = (LAS float*)lds + w * (16 * 81 + 16);
    LAS int* lcnt = (LAS int*)(lds + 8 * (16 * 81 + 16) * 4);
    constexpr int RT_WB = 8 * (16 * 81 + 16) * 4 + 1024;
    for (int tile = blockIdx.x; tile < NX / 128; tile += gridDim.x) {
        __syncthreads();
        if (tid < 64) lcnt[tid] = 0;
        __syncthreads();
        const int xr0 = tile * 128 + w * 16;
        const bf16* hrow = p.h1 + (size_t)(xr0 + i) * D + 8 * g;
        f32x4 acc[5];
#pragma unroll
        for (int nt = 0; nt < 5; ++nt) acc[nt] = (f32x4){0.f, 0.f, 0.f, 0.f};
        float ss = 0.f;
        u32x4 wv[10];
#define RT_LOADW(kc_) { _Pragma("unroll") for (int j = 0; j < 10; ++j) { const int x = tid + 512 * j, pl = x / 2560, rem = x % 2560, n = rem >> 5, c16 = rem & 31; \
            wv[j] = *(const u32x4*)(p.Wr + (size_t)pl * 80 * 1024 + (size_t)n * 1024 + (kc_) * 256 + c16 * 8); } }
        RT_LOADW(0)
        for (int kc = 0; kc < 4; ++kc) {
            __syncthreads();
#pragma unroll
            for (int j = 0; j < 10; ++j) { const int x = tid + 512 * j, pl = x / 2560, rem = x % 2560, n = rem >> 5, c16 = rem & 31;
                *(LAS u32x4*)(lds + RT_WB + (pl * 80 + n) * 512 + ((c16 * 16) ^ (((pl * 80 + n) & 15) << 4))) = wv[j]; }
            __syncthreads();
            if (kc < 3) RT_LOADW(kc + 1)
#pragma unroll 4
            for (int k8 = 0; k8 < 8; ++k8) {
                const u32x4 hv = *(const u32x4*)(hrow + kc * 256 + 32 * k8);
                const float h0 = bflo(hv.x), h1_ = bfhi(hv.x), h2 = bflo(hv.y), h3 = bfhi(hv.y), h4 = bflo(hv.z), h5 = bfhi(hv.z), h6 = bflo(hv.w), h7 = bfhi(hv.w);
                ss += (h0 * h0 + h1_ * h1_) + (h2 * h2 + h3 * h3) + (h4 * h4 + h5 * h5) + (h6 * h6 + h7 * h7);
                const bf16x8 Ah = __builtin_bit_cast(bf16x8, hv);
#pragma unroll
                for (int nt = 0; nt < 5; ++nt) {
                    const bf16x8 bh = *(const LAS bf16x8*)(lds + RT_WB + (16 * nt + i) * 512 + (((32 * k8 + 8 * g) * 2) ^ (i << 4))), bl = *(const LAS bf16x8*)(lds + RT_WB + (80 + 16 * nt + i) * 512 + (((32 * k8 + 8 * g) * 2) ^ (i << 4)));
                    acc[nt] = __builtin_amdgcn_mfma_f32_16x16x32_bf16(Ah, bh, acc[nt], 0, 0, 0);
                    acc[nt] = __builtin_amdgcn_mfma_f32_16x16x32_bf16(Ah, bl, acc[nt], 0, 0, 0);
                }
            }
        }
#undef RT_LOADW
        ss += __shfl_xor(ss, 16); ss += __shfl_xor(ss, 32);
        if (g == 0) lg[16 * 81 + i] = rsqrtf(ss * (1.0f / D) + EPS);
#pragma unroll
        for (int nt = 0; nt < 5; ++nt)
#pragma unroll
            for (int r = 0; r < 4; ++r) lg[(4 * g + r) * 81 + 16 * nt + i] = acc[nt][r];
        asm volatile("s_waitcnt lgkmcnt(0)" ::: "memory");
        int x0 = 0, x1 = 0, l0 = 0, l1 = 0; float gate0 = 0.f, gate1 = 0.f, rs = 0.f;
        if (lane < 16) {
            const LAS float* row = lg + lane * 81; rs = lg[16 * 81 + lane];
            float lgv[8];
#pragma unroll
            for (int q = 0; q < 8; ++q) lgv[q] = row[q] * rs;
            int gs = 0; float best = lgv[0];
#pragma unroll
            for (int q = 1; q < 8; ++q) if (lgv[q] > best) { best = lgv[q]; gs = q; }
            float den = 0.f;
#pragma unroll
            for (int q = 0; q < 8; ++q) den += __expf(lgv[q] - best);
            const float pgroup = 1.0f / den;
            float le[8];
#pragma unroll
            for (int q = 0; q < 8; ++q) le[q] = row[8 + gs * 8 + q] * rs;
            int e0 = 0; float b0 = le[0];
#pragma unroll
            for (int q = 1; q < 8; ++q) if (le[q] > b0) { b0 = le[q]; e0 = q; }
            int e1 = -1; float b1 = -3.0e38f;
#pragma unroll
            for (int q = 0; q < 8; ++q) if (q != e0 && le[q] > b1) { b1 = le[q]; e1 = q; }
            const float q1 = __expf(b1 - b0), inv = 1.0f / (1.0f + q1);
            x0 = gs * 8 + e0; x1 = gs * 8 + e1; gate0 = pgroup * inv; gate1 = pgroup * q1 * inv;
            if (!DRY) { l0 = atomicAdd((int*)(lcnt + x0), 1); l1 = atomicAdd((int*)(lcnt + x1), 1); }
        }
        __syncthreads();
        if (!DRY && tid < 64) { const int c = lcnt[tid]; lcnt[64 + tid] = c ? (int)atomicAdd(p.cnt + tid, (unsigned)c) : 0; }
        __syncthreads();
        if (!DRY && lane < 16) {
            const int xr = xr0 + lane, r0 = lcnt[64 + x0] + l0, r1 = lcnt[64 + x1] + l1;
            p.rstd[xr] = rs;
            p.list[(size_t)x0 * NX + r0] = xr; p.list[(size_t)x1 * NX + r1] = xr; p.rsl[(size_t)x0 * NX + r0] = rs; p.rsl[(size_t)x1 * NX + r1] = rs;
            p.asg_e[xr * 2] = x0; p.asg_e[xr * 2 + 1] = x1; p.asg_rank[xr * 2] = r0; p.asg_rank[xr * 2 + 1] = r1;
            p.asg_gate[xr * 2] = gate0; p.asg_gate[xr * 2 + 1] = gate1;
        }
    }
    __syncthreads();
}

__device__ __forceinline__ void moe_tables(const P& p, int* tb) {
    __syncthreads();
    if (threadIdx.x < NE) {
        const int e = threadIdx.x, c = (int)xb_ld(p.cnt + e), ntl = (c + 255) >> 8;
        const int incl = (int)(wave_incl_scan((float)ntl) + 0.5f), t0 = incl - ntl;
        tb[e] = c; tb[64 + e] = t0 * 256;
        for (int j = 0; j < ntl; ++j) { tb[192 + t0 + j] = e; tb[512 + t0 + j] = j * 256; }
        if (e == NE - 1) { tb[128] = incl * 256; tb[129] = incl; }
    }
    __syncthreads();
}
struct MoeOrder { const int* tb; int G, c, lo = 64;
    __device__ __forceinline__ bool next(int i, Unit& u) const {
        int rt, pn;
        if ((G & 31) == 0) { const int x = c & 7, q = c >> 3; rt = i * (G >> 2) + x * (G >> 5) + (q >> 2); pn = q & 3; }
        else { const int Lx = i * G + c; rt = Lx >> 2; pn = Lx & 3; }
        if (lo < 64) { if (rt >= lo) rt += 64 - lo; }
        if (rt >= tb[129]) return false;
        u.pm = rt; u.pn = pn; u.e = tb[192 + rt]; u.r0 = tb[512 + rt]; return true; } };
struct GMoe1 { static constexpr bool GATHER = true; const char* A; int kstepA, K; const char* Bt; const int* list; const int* tb;
    __device__ __forceinline__ unsigned aoff(const Unit& u, int r, int C) const { const int rr = u.r0 + r; const int xr = rr < tb[u.e] ? list[(size_t)u.e * NX + rr] : 0; return (unsigned)xr * (D * 2) + (unsigned)(C * 2); }
    __device__ __forceinline__ const char* bptr(const Unit& u) const { return Bt + ((size_t)u.e * 1024 + (size_t)u.pn * BM) * D * 2; } };
struct EpiMoe1 { static constexpr bool PERM = true; bf16* hid; const float* rsl; const int* tb;
    __device__ __forceinline__ void operator()(const f32x4 (&acc)[2][2][4][2], const Unit& u, int wr, int wc, int fr, int fq) const {
        const int cnt = tb[u.e], s0 = tb[64 + u.e] + u.r0;
#pragma unroll
        for (int ai = 0; ai < 2; ++ai)
#pragma unroll
            for (int m = 0; m < 4; ++m) { const int r = ai * HALF + wr * 64 + m * 16 + fr, rr = u.r0 + r; const float rs = rr < cnt ? rsl[(size_t)u.e * NX + rr] : 0.f;
                const f32x4 g0 = acc[ai][0][m][0] * rs, u0 = acc[ai][1][m][0] * rs, g1 = acc[ai][0][m][1] * rs, u1 = acc[ai][1][m][1] * rs;
                u32x4 o; o.x = cvt_pk_bf16(siluf_(g0[0]) * u0[0], siluf_(g0[1]) * u0[1]); o.y = cvt_pk_bf16(siluf_(g0[2]) * u0[2], siluf_(g0[3]) * u0[3]);
                o.z = cvt_pk_bf16(siluf_(g1[0]) * u1[0], siluf_(g1[1]) * u1[1]); o.w = cvt_pk_bf16(siluf_(g1[2]) * u1[2], siluf_(g1[3]) * u1[3]);
                *(u32x4*)(hid + blk16(s0 + r, u.pn * HALF + wc * 32 + 8 * fq, DE / 16)) = o; }
    } };
struct GMoe2 { static constexpr bool GATHER = false; const char* A; int kstepA, K; const char* Bt; const int* tb;
    __device__ __forceinline__ unsigned aoff(const Unit& u, int r, int C) const { return (unsigned)(blk16(tb[64 + u.e] + u.r0 + r, C, DE / 16) * 2); }
    __device__ __forceinline__ const char* bptr(const Unit& u) const { return Bt + ((size_t)u.e * 1024 + (size_t)u.pn * BM) * DE * 2; } };
struct EpiMoe2 { static constexpr bool PERM = true; bf16* y; const int* tb;
    __device__ __forceinline__ void operator()(const f32x4 (&acc)[2][2][4][2], const Unit& u, int wr, int wc, int fr, int fq) const {
        const int s0 = tb[64 + u.e] + u.r0;
#pragma unroll
        for (int ai = 0; ai < 2; ++ai)
#pragma unroll
            for (int m = 0; m < 4; ++m) { const int row = s0 + ai * HALF + wr * 64 + m * 16 + fr, col0 = u.pn * BM + wc * 32 + 8 * fq;
#pragma unroll
                for (int bj = 0; bj < 2; ++bj) { const f32x4 v0 = acc[ai][bj][m][0], v1 = acc[ai][bj][m][1];
                    u32x4 o; o.x = cvt_pk_bf16(v0[0], v0[1]); o.y = cvt_pk_bf16(v0[2], v0[3]); o.z = cvt_pk_bf16(v1[0], v1[1]); o.w = cvt_pk_bf16(v1[2], v1[3]);
                    *(u32x4*)(y + (size_t)row * D + col0 + bj * HALF) = o; } }
    } };
struct OneUnit { Unit u; __device__ __forceinline__ bool next(int i, Unit& o) const { if (i) return false; o = u; return true; } };
__device__ __forceinline__ void ph_moe1(const P& p, LAS unsigned char* lds, const int* tb) {
    GMoe1 g{(const char*)p.h1, BK * 2, D, (const char*)p.Wgu, p.list, tb}; MoeOrder S{tb, (int)gridDim.x, (int)blockIdx.x}; EpiMoe1 E{p.hid, p.rsl, tb};
    gemm_phase(lds, g, S, E);
    const int nt = tb[129], G = (int)gridDim.x, c = (int)blockIdx.x, lo = nt - 256;
    if (G == 256 && lo > 0 && lo < 64) {
        const int x = c & 7, q = c >> 3, rt0 = x * 8 + (q >> 2), grp = x * 8 + (q >> 2);
        if (rt0 >= lo) {
            asm volatile("s_waitcnt vmcnt(0)" ::: "memory");
            __syncthreads();
            if (threadIdx.x == 0) {
                xb_add(p.cnt + 128 + grp, 1u);
                XB_SPIN(xb_ld(p.cnt + 128 + grp) < 4u, p.bar);
                __builtin_amdgcn_fence(__ATOMIC_ACQUIRE, "agent");
                asm volatile("s_waitcnt vmcnt(0)" ::: "memory");
            }
            __syncthreads();
            GMoe2 g2{(const char*)p.hid, 4 * 512, DE, (const char*)p.Wd, tb}; EpiMoe2 E2{p.y, tb};
            OneUnit S2; S2.u.pm = rt0; S2.u.pn = q & 3; S2.u.e = tb[192 + rt0]; S2.u.r0 = tb[512 + rt0];
            gemm_phase(lds, g2, S2, E2);
        }
    }
}
__device__ __forceinline__ void ph_moe2(const P& p, LAS unsigned char* lds, const int* tb) {
    GMoe2 g{(const char*)p.hid, 4 * 512, DE, (const char*)p.Wd, tb}; MoeOrder S{tb, (int)gridDim.x, (int)blockIdx.x}; EpiMoe2 E{p.y, tb};
    { const int lo = tb[129] - 256; if ((int)gridDim.x == 256 && lo > 0 && lo < 64) S.lo = lo; }
    gemm_phase(lds, g, S, E);
}
__device__ __forceinline__ void ph_final(const P& p, const int* tb) {
    const int* soff = tb + 64;
    int tid_ = threadIdx.x; asm volatile("" : "+v"(tid_));
    const int lane = tid_ & 63, wpb = blockDim.x >> 6;
    const int wave = blockIdx.x * wpb + (tid_ >> 6), nw = gridDim.x * wpb;
    float gn[16];
#pragma unroll
    for (int q = 0; q < 4; ++q) { const float4 g4 = ((const float4*)p.norm_final)[lane * 4 + q]; gn[4 * q] = g4.x; gn[4 * q + 1] = g4.y; gn[4 * q + 2] = g4.z; gn[4 * q + 3] = g4.w; }
    const bool bad = xb_ld(p.bar + XB_TMO) != 0u;
    for (int xr0 = wave; xr0 < NX; xr0 += 2 * nw) {
        const int xrs[2] = {xr0, xr0 + nw < NX ? xr0 + nw : xr0};
        u32x4 hv[2][2], av[2][2], cv[2][2]; float g0[2], g1[2];
#pragma unroll
        for (int q = 0; q < 2; ++q) {
            const int xr = xrs[q];
            const int s0 = soff[p.asg_e[xr * 2]] + p.asg_rank[xr * 2], s1 = soff[p.asg_e[xr * 2 + 1]] + p.asg_rank[xr * 2 + 1];
            g0[q] = p.asg_gate[xr * 2]; g1[q] = p.asg_gate[xr * 2 + 1];
            const bf16* hp = p.h1 + (size_t)xr * D + 16 * lane; const bf16* y0 = p.y + (size_t)s0 * D + 16 * lane; const bf16* y1 = p.y + (size_t)s1 * D + 16 * lane;
            hv[q][0] = *(const u32x4*)hp; hv[q][1] = *(const u32x4*)(hp + 8); av[q][0] = *(const u32x4*)y0; av[q][1] = *(const u32x4*)(y0 + 8); cv[q][0] = *(const u32x4*)y1; cv[q][1] = *(const u32x4*)(y1 + 8);
        }
#pragma unroll
        for (int q = 0; q < 2; ++q) {
            float v[16]; float ss = 0.f;
#pragma unroll
            for (int hq = 0; hq < 2; ++hq) {
                const unsigned hw[4] = {hv[q][hq].x, hv[q][hq].y, hv[q][hq].z, hv[q][hq].w}, aw[4] = {av[q][hq].x, av[q][hq].y, av[q][hq].z, av[q][hq].w}, cw[4] = {cv[q][hq].x, cv[q][hq].y, cv[q][hq].z, cv[q][hq].w};
#pragma unroll
                for (int e = 0; e < 4; ++e) { v[8 * hq + 2 * e] = bflo(hw[e]) + g0[q] * bflo(aw[e]) + g1[q] * bflo(cw[e]); v[8 * hq + 2 * e + 1] = bfhi(hw[e]) + g0[q] * bfhi(aw[e]) + g1[q] * bfhi(cw[e]); }
            }
#pragma unroll
            for (int e = 0; e < 16; ++e) ss += v[e] * v[e];
            ss = wave_sum(ss);
            float r = rsqrtf(ss * (1.0f / D) + EPS);
            if (bad) r = __builtin_nanf("");
            float* op = p.out + (size_t)xrs[q] * D + 16 * lane;
#pragma unroll
            for (int e4 = 0; e4 < 4; ++e4) *(float4*)(op + 4 * e4) = make_float4(v[4 * e4] * r * gn[4 * e4], v[4 * e4 + 1] * r * gn[4 * e4 + 1], v[4 * e4 + 2] * r * gn[4 * e4 + 2], v[4 * e4 + 3] * r * gn[4 * e4 + 3]);
        }
    }
}

constexpr int LDS_SCR = HY_END > STAGE_BYTES ? HY_END : STAGE_BYTES;
constexpr int LDS_BAR = LDS_SCR, LDS_TB = LDS_SCR + 64, LDS_BYTES = LDS_SCR + 64 + 4096;
static_assert(LDS_BYTES <= 160 * 1024 && HG_END <= LDS_SCR, "LDS");

__global__ void __launch_bounds__(512, 2) k_mega(P p) {
    extern __shared__ __attribute__((aligned(16))) unsigned char smraw[];
    float* sm = (float*)smraw;
    LAS unsigned char* lds = (LAS unsigned char*)smraw;
    int* tb = (int*)(smraw + LDS_TB);
    if (threadIdx.x == 0) *(uint4*)(smraw + LDS_BAR) = make_uint4(0u, 0u, 0u, 0u);
    __syncthreads();
    XcdBarrier bar = xcd_barrier_post(p.bar, (volatile LAS unsigned*)(smraw + LDS_BAR));

    if (blockIdx.x & 1) { ph_filters(p, sm); ph_conv_router(p); ph_conv<1>(p, sm, 0, 3); ph_norm1(p); }
    else { ph_norm1(p); ph_conv<1>(p, sm, 0, 3); ph_conv_router(p); ph_filters(p, sm); }
    xcd_barrier(bar);


    const int sg = (blockIdx.x >> 3) & 3;

    ph_conv<2>(p, sm, 0, (4 / 4) * sg);
    ph_inproj(p, lds);
    ph_conv<2>(p, sm, (4 / 4) * sg, 4);
    xcd_barrier(bar);


    ph_mixers(p, lds, (LAS int*)(smraw + LDS_TB));
    xcd_barrier(bar);


    ph_buildA2(p, lds);
    xcd_barrier(bar);


    ph_conv<0>(p, sm, 0, 1 << 20);
    ph_outproj(p, lds);
    xcd_barrier(bar);


    ph_router<false>(p, lds);
    xcd_barrier(bar);


    moe_tables(p, tb);
    ph_moe1(p, lds, tb);
    xcd_barrier(bar);


    ph_moe2(p, lds, tb);
    xcd_barrier(bar);


    ph_final(p, tb);

}

struct Alloc { size_t off = 0; size_t take(size_t bytes) { const size_t o = off; off += (bytes + 255) & ~(size_t)255; return o; } };
}

extern "C" void kernel_launch(void* const* d_in, const int* in_sizes, int n_in, void* d_out, int out_size, void* d_ws, size_t ws_size, hipStream_t stream) {
    (void)in_sizes; (void)n_in; (void)out_size;
    char* ws = (char*)d_ws;
    P p{};
    const float** ins[] = {&p.x, &p.meta, &p.w_in, &p.conv_w, &p.conv_b, &p.fw1, &p.fb1, &p.fw2, &p.fb2, &p.fw3, &p.ffreq, &p.fskip, &p.hy_norm, &p.lb_f, &p.lb_b,
                           &p.hg_norm, &p.w_out, &p.norm_mix, &p.norm_ffn, &p.w_rg, &p.w_re, &p.w_gate, &p.w_up, &p.w_down, &p.norm_final};
    for (int i = 0; i < 25; ++i) *ins[i] = (const float*)d_in[i];
    p.out = (float*)d_out;
    Alloc a;
    const size_t o_zero = a.take(65536);
    const size_t o_A = a.take((size_t)NX * D * 2);
    const size_t o_Preg = a.off;
    const size_t o_pT = a.take((size_t)NHY * BATCH * LP * 2);
    const size_t o_pg = a.take((size_t)NTOK * NHG * 2);
    const size_t o_G = a.take((size_t)1024 * GL * 2);
    const size_t o_W1t = a.take((size_t)NPROJ * D * 2);
    const size_t o_Hreg = a.off;
    const size_t o_z2 = a.take((size_t)DH * BATCH * LP * 2);
    const size_t o_o = a.take((size_t)2 * NTOK * DG * 2);
    if (a.off < o_Hreg + (size_t)NX * D * 2) a.off = o_Hreg + (size_t)NX * D * 2;
    const size_t o_W2t = a.take((size_t)D * D * 2);
    const size_t o_Wd = a.take((size_t)NE * 1024 * DE * 2);
    const size_t o_Wr = a.take((size_t)2 * 80 * 1024 * 2);
    const size_t o_Am = a.take((size_t)NMETA * D * 2);
    const size_t o_list = a.take((size_t)NE * NX * 4);
    const size_t o_rstd = a.take((size_t)NX * 4);
    const size_t o_rsl = a.take((size_t)NE * NX * 4);
    const size_t o_ae = a.take((size_t)NX * 2 * 4), o_ar = a.take((size_t)NX * 2 * 4), o_ag = a.take((size_t)NX * 2 * 4);
    const size_t sz_wgu = (size_t)NE * 1024 * 1024 * 2, sz_hid = (size_t)MAXSLOT * DE * 2, sz_wd = (size_t)NE * 1024 * DE * 2, sz_y = (size_t)MAXSLOT * D * 2;
    const size_t o_Wgu = o_Preg, o_hid = o_Wgu + sz_wgu, o_y = o_A, o_h1 = o_Hreg;
    (void)sz_wd;
    if (a.off > ws_size || o_hid + sz_hid > o_G || o_y + sz_y > o_Wgu + sz_wgu || o_h1 + (size_t)NX * D * 2 > o_W2t) {
        fprintf(stderr, "workspace map does not fit: need %zu have %zu\n", a.off, ws_size); return; }
    p.bar = (unsigned*)(ws + o_zero); p.cnt = p.bar + 8192;
    p.A = (bf16*)(ws + o_A); p.pT = (bf16*)(ws + o_pT); p.pg = (bf16*)(ws + o_pg); p.G = (bf16*)(ws + o_G); p.z2 = (bf16*)(ws + o_z2); p.o = (bf16*)(ws + o_o);
    p.h1 = (bf16*)(ws + o_h1); p.rstd = (float*)(ws + o_rstd); p.list = (int*)(ws + o_list); p.rsl = (float*)(ws + o_rsl); p.asg_e = (int*)(ws + o_ae); p.asg_rank = (int*)(ws + o_ar); p.asg_gate = (float*)(ws + o_ag);
    p.hid = (bf16*)(ws + o_hid); p.y = (bf16*)(ws + o_y);
    p.W1t = (bf16*)(ws + o_W1t); p.W2t = (bf16*)(ws + o_W2t); p.Wgu = (bf16*)(ws + o_Wgu); p.Wd = (bf16*)(ws + o_Wd); p.Wr = (bf16*)(ws + o_Wr); p.Am = (bf16*)(ws + o_Am);
    hipMemsetAsync(ws + o_zero, 0, 65536, stream);
    static int grid = 0;
    if (!grid) {
        int dev = 0, cus = 0, per_cu = 0;
        hipGetDevice(&dev);
        hipDeviceGetAttribute(&cus, hipDeviceAttributeMultiprocessorCount, dev);
        if (hipFuncSetAttribute((const void*)k_mega, hipFuncAttributeMaxDynamicSharedMemorySize, LDS_BYTES) != hipSuccess) { fprintf(stderr, "hipFuncSetAttribute failed\n"); return; }
        hipOccupancyMaxActiveBlocksPerMultiprocessor(&per_cu, (const void*)k_mega, 512, LDS_BYTES);
        if (per_cu < 1) { fprintf(stderr, "occupancy query says 0 blocks per CU\n"); return; }
        grid = cus;
    }
    k_mega<<<grid, 512, LDS_BYTES, stream>>>(p);
}
```
